# Optimizing an MI355X kernel written in HIP

```python
import jax, jax.numpy as jnp
from jax import lax
import numpy as np

D_MODEL = 1024
BATCH = 8
SEQ = 2048
DEPTH = 4

N_MIXERS = 3
EPS = 1e-6
N_NORMS = 6
D_FF = 2816
CONV_W = 3
ATT_HEADS = 16
ATT_HD = 64
DILATION_PAIRS = ((128, 1), (512, 4), (2048, 16))
N_GROUPS = len(DILATION_PAIRS)
ATT_BLOCK = 128
ROPE_THETA = 500000.0
ROT_DIM = ATT_HD // 4
ML_HEADS = 4
ML_DQK = 128
ML_DV = D_MODEL // ML_HEADS
ML_CHUNK = 64
ML_PROJ = 2 * ML_HEADS * ML_DQK + 2 * ML_HEADS * ML_DV + 2 * ML_HEADS
N_CONV_LAYERS = (DEPTH + 2) // 3
N_ATTN_LAYERS = (DEPTH + 1) // 3
N_MLSTM_LAYERS = DEPTH // 3

kernel_name = "hybrid_conv_dilattn_mlstm_macaron"


def rmsnorm(x, g):
    x32 = x.astype(jnp.float32)
    y = x32 * lax.rsqrt(jnp.mean(x32 * x32, axis=-1, keepdims=True) + EPS)
    return (y * g.astype(jnp.float32)).astype(x.dtype)


def swiglu(x, wg, wu, wd):
    return (jax.nn.silu(x @ wg) * (x @ wu)) @ wd


def short_conv_mixer(x, w_in, k, w_out):
    S = x.shape[1]
    b, c, u = jnp.split(x @ w_in, 3, axis=-1)
    u = c * u
    up = jnp.pad(u, ((0, 0), (CONV_W - 1, 0), (0, 0)))
    conv = sum(k[j] * up[:, CONV_W - 1 - j:CONV_W - 1 - j + S] for j in range(CONV_W))
    return (b * conv) @ w_out


def rope_tables(S):
    pos = jnp.arange(S, dtype=jnp.float32)
    inv = ROPE_THETA ** (-jnp.arange(0, ROT_DIM, 2, dtype=jnp.float32) / ROT_DIM)
    ang = pos[:, None] * inv[None, :]
    return jnp.cos(ang), jnp.sin(ang)


def apply_partial_rope(x, cos, sin):
    half = ROT_DIM // 2
    x1, x2, rest = x[..., :half], x[..., half:ROT_DIM], x[..., ROT_DIM:]
    c, s = cos[None, :, None, :], sin[None, :, None, :]
    return jnp.concatenate([x1 * c - x2 * s, x2 * c + x1 * s, rest], axis=-1).astype(x.dtype)


def dilated_window_attention(q, k, v, win, dil):
    B, S, H, hd = q.shape
    L = S // dil
    nb = -(-L // ATT_BLOCK)
    Lp = nb * ATT_BLOCK

    def to_sub(t):
        t = t.reshape(B, L, dil, H, hd).transpose(0, 2, 3, 1, 4)
        t = jnp.pad(t, ((0, 0), (0, 0), (0, 0), (0, Lp - L), (0, 0)))
        return t.reshape(B, dil, H, nb, ATT_BLOCK, hd)

    def with_prev(t):
        prev = jnp.pad(t, ((0, 0), (0, 0), (0, 0), (1, 0), (0, 0), (0, 0)))[:, :, :, :-1]
        return jnp.concatenate([prev, t], axis=-2)

    qb = to_sub(q)
    kk = with_prev(to_sub(k))
    vv = with_prev(to_sub(v)).astype(jnp.float32)
    scores = jnp.einsum('brhnqd,brhnkd->brhnqk', qb, kk,
                        preferred_element_type=jnp.float32) * (hd ** -0.5)
    qi = jnp.arange(ATT_BLOCK)[:, None] + ATT_BLOCK
    kj = jnp.arange(2 * ATT_BLOCK)[None, :]
    rel = qi - kj
    band = (rel >= 0) & (rel <= win)
    key_ok = (jnp.arange(nb)[:, None] * ATT_BLOCK - ATT_BLOCK + kj) >= 0
    mask = band[None] & key_ok[:, None, :]
    scores = jnp.where(mask, scores, -jnp.inf)
    m = jnp.max(scores, axis=-1, keepdims=True)
    p = jnp.exp(scores - m)
    den = jnp.sum(p, axis=-1)
    out = jnp.einsum('brhnqk,brhnkd->brhnqd', p, vv) / den[..., None]
    lse = m[..., 0] + jnp.log(den)
    out = out.reshape(B, dil, H, Lp, hd)[:, :, :, :L].transpose(0, 3, 1, 2, 4).reshape(B, S, H, hd)
    lse = lse.reshape(B, dil, H, Lp)[..., :L].transpose(0, 3, 1, 2).reshape(B, S, H)
    return out, lse


def dilated_attention_mixer(x, w_in, w_out, cos, sin):
    B, S, _ = x.shape
    qkv = (x @ w_in).reshape(B, S, N_GROUPS, 3, ATT_HEADS, ATT_HD)
    outs, lses = [], []
    for g, (win, dil) in enumerate(DILATION_PAIRS):
        q = apply_partial_rope(qkv[:, :, g, 0], cos, sin)
        k = apply_partial_rope(qkv[:, :, g, 1], cos, sin)
        v = qkv[:, :, g, 2]
        o, l = dilated_window_attention(q, k, v, win // dil, dil)
        outs.append(o)
        lses.append(l)
    alpha = jax.nn.softmax(jnp.stack(lses, axis=0), axis=0)
    o = jnp.sum(alpha[..., None] * jnp.stack(outs, axis=0), axis=0)
    return o.reshape(B, S, ATT_HEADS * ATT_HD).astype(x.dtype) @ w_out


def mlstm_mixer(x, w_in, b_i, b_f, w_out):
    B, S, _ = x.shape
    NH, L = ML_HEADS, ML_CHUNK
    nc = S // L
    p = x @ w_in
    o1 = NH * ML_DQK
    o2 = 2 * o1
    o3 = o2 + NH * ML_DV
    o4 = o3 + NH * ML_DV
    o5 = o4 + NH
    q = p[..., :o1].reshape(B, S, NH, ML_DQK).astype(jnp.float32)
    k = p[..., o1:o2].reshape(B, S, NH, ML_DQK).astype(jnp.float32) * (ML_DQK ** -0.5)
    v = p[..., o2:o3].reshape(B, S, NH, ML_DV).astype(jnp.float32)
    og = jax.nn.sigmoid(p[..., o3:o4].astype(jnp.float32))
    ig = (p[..., o4:o5] + b_i).astype(jnp.float32)
    lf = jax.nn.log_sigmoid((p[..., o5:] + b_f).astype(jnp.float32))

    def vec_chunks(t):
        return t.reshape(B, nc, L, NH, -1).transpose(1, 0, 3, 2, 4)

    def gate_chunks(t):
        return t.reshape(B, nc, L, NH).transpose(1, 0, 3, 2)

    tril = jnp.tril(jnp.ones((L, L), dtype=bool))

    def step(carry, inp):
        C, n, m = carry
        qc, kc, vc, ic, fc = inp
        b = jnp.cumsum(fc, axis=-1)
        dlog = jnp.where(tril, b[..., :, None] - b[..., None, :] + ic[..., None, :], -jnp.inf)
        inter = b + m[..., None]
        mt = jnp.maximum(inter, jnp.max(dlog, axis=-1))
        w = jnp.exp(dlog - mt[..., None])
        wi = jnp.exp(inter - mt)
        a = jnp.einsum('bhtd,bhsd->bhts', qc, kc) * w
        num = jnp.einsum('bhts,bhsv->bhtv', a, vc) + wi[..., None] * jnp.einsum('bhvd,bhtd->bhtv', C, qc)
        den = jnp.sum(a, axis=-1) + wi * jnp.einsum('bhd,bhtd->bht', n, qc)
        h = num / jnp.maximum(jnp.abs(den), jnp.exp(-mt))[..., None]
        m_new = mt[..., -1]
        we = jnp.exp(b[..., -1:] - b + ic - m_new[..., None])
        decay = jnp.exp(b[..., -1] + m - m_new)
        C = decay[..., None, None] * C + jnp.einsum('bhs,bhsv,bhsd->bhvd', we, vc, kc)
        n = decay[..., None] * n + jnp.einsum('bhs,bhsd->bhd', we, kc)
        return (C, n, m_new), h

    init = (jnp.zeros((B, NH, ML_DV, ML_DQK), jnp.float32),
            jnp.zeros((B, NH, ML_DQK), jnp.float32),
            jnp.zeros((B, NH), jnp.float32))
    _, h = lax.scan(step, init, (vec_chunks(q), vec_chunks(k), vec_chunks(v),
                                 gate_chunks(ig), gate_chunks(lf)))
    h = h.transpose(1, 0, 3, 2, 4).reshape(B, S, NH * ML_DV)
    return (h * og).astype(x.dtype) @ w_out


def setup_inputs(seed: int = 0) -> dict:
    key = jax.random.key(seed)
    ks = jax.random.split(key, 18)
    D = D_MODEL

    def w(k, shape, fan_in):
        return jax.random.normal(k, shape, jnp.float32) * fan_in ** -0.5

    return {
        "x": jax.random.normal(ks[0], (BATCH, SEQ, D), jnp.float32),
        "norm_g": 1.0 + 0.05 * jax.random.normal(ks[1], (DEPTH, N_NORMS, D), jnp.float32),
        "ffn1_wg": w(ks[2], (DEPTH, D, D_FF), D),
        "ffn1_wu": w(ks[3], (DEPTH, D, D_FF), D),
        "ffn1_wd": w(ks[4], (DEPTH, D_FF, D), D_FF),
        "ffn2_wg": w(ks[5], (DEPTH, D, D_FF), D),
        "ffn2_wu": w(ks[6], (DEPTH, D, D_FF), D),
        "ffn2_wd": w(ks[7], (DEPTH, D_FF, D), D_FF),
        "conv_w_in": w(ks[8], (N_CONV_LAYERS, D, 3 * D), D),
        "conv_k": w(ks[9], (N_CONV_LAYERS, CONV_W, D), CONV_W),
        "conv_w_out": w(ks[10], (N_CONV_LAYERS, D, D), D),
        "attn_w_in": w(ks[11], (N_ATTN_LAYERS, D, N_GROUPS * 3 * ATT_HEADS * ATT_HD), D),
        "attn_w_out": w(ks[12], (N_ATTN_LAYERS, ATT_HEADS * ATT_HD, D), ATT_HEADS * ATT_HD),
        "mlstm_w_in": w(ks[13], (N_MLSTM_LAYERS, D, ML_PROJ), D),
        "mlstm_b_i": 0.01 * jax.random.normal(ks[14], (N_MLSTM_LAYERS, ML_HEADS), jnp.float32),
        "mlstm_b_f": jnp.linspace(3.0, 6.0, ML_HEADS, dtype=jnp.float32)[None, :]
                     + 0.01 * jax.random.normal(ks[15], (N_MLSTM_LAYERS, ML_HEADS), jnp.float32),
        "mlstm_w_out": w(ks[16], (N_MLSTM_LAYERS, ML_HEADS * ML_DV, D), ML_HEADS * ML_DV),
    }


def reference(x, norm_g, ffn1_wg, ffn1_wu, ffn1_wd, ffn2_wg, ffn2_wu, ffn2_wd,
              conv_w_in, conv_k, conv_w_out, attn_w_in, attn_w_out,
              mlstm_w_in, mlstm_b_i, mlstm_b_f, mlstm_w_out):
    cos, sin = rope_tables(x.shape[1])
    for i in range(DEPTH):
        g = norm_g[i]
        x = x + 0.5 * rmsnorm(swiglu(rmsnorm(x, g[0]), ffn1_wg[i], ffn1_wu[i], ffn1_wd[i]), g[1])
        xn = rmsnorm(x, g[2])
        mixer, j = i % N_MIXERS, i // N_MIXERS
        if mixer == 0:
            y = short_conv_mixer(xn, conv_w_in[j], conv_k[j], conv_w_out[j])
        elif mixer == 1:
            y = dilated_attention_mixer(xn, attn_w_in[j], attn_w_out[j], cos, sin)
        else:
            y = mlstm_mixer(xn, mlstm_w_in[j], mlstm_b_i[j], mlstm_b_f[j], mlstm_w_out[j])
        x = x + rmsnorm(y, g[3])
        x = x + 0.5 * rmsnorm(swiglu(rmsnorm(x, g[4]), ffn2_wg[i], ffn2_wu[i], ffn2_wd[i]), g[5])
    return x
```

```cpp
#include <hip/hip_runtime.h>
#include <cstdio>
#include <cstdint>
#include <cmath>
namespace pg8 {
#define PG8_LAS __attribute__((address_space(3)))
typedef unsigned short bf16_t;
typedef short bf16x8 __attribute__((ext_vector_type(8)));
typedef float f32x4 __attribute__((ext_vector_type(4)));
typedef unsigned u32x4 __attribute__((ext_vector_type(4)));
constexpr int BM = 256, BK = 64, HALF = 128, HTB = HALF * BK * 2  , STAGE_BYTES = 8 * HTB, NXCD = 8, WGM = 8;

__host__ __device__ __forceinline__ int lds_byte(int r, int c) { const int st = (r >> 4) * 2 + (c >> 5), rr = r & 15, cc = c & 31, ob = rr * 64 + cc * 2; return st * 1024 + (ob ^ (((ob >> 9) & 1) << 5)); }
__host__ __device__ __forceinline__ void stage_rc(int b, int& R, int& C) { const int st = b / 1024, sb = b % 1024, swz = sb ^ (((sb >> 9) & 1) << 5); R = (st >> 1) * 16 + swz / 64; C = (st & 1) * 32 + (swz % 64) / 2; }
__host__ __device__ __forceinline__ int perm32(int rho) { const int n = rho >> 4, i = rho & 15; return 8 * (i >> 2) + 4 * n + (i & 3); }

struct Unit { int pm, pn; };
struct StaticOrder {
    int nM, nN, nwg, G, c;
    __host__ __device__ void init(int M, int N, int G_, int c_) { nM = M / BM; nN = N / BM; nwg = nM * nN; G = G_; c = c_; }
    __host__ __device__ bool next(int i, Unit& u) const {
        const long L = (long)i * G + c; if (L >= nwg) return false;
        int wgid = (int)L; { const int q = nwg / NXCD, r = nwg % NXCD, xcd = wgid % NXCD, off = wgid / NXCD; wgid = (xcd < r ? xcd * (q + 1) : r * (q + 1) + (xcd - r) * q) + off; }
        const int nig = WGM * nN, gid = wgid / nig, fm = gid * WGM, gsz = (nM - fm) < WGM ? (nM - fm) : WGM;
        u.pm = fm + ((wgid % nig) % gsz); u.pn = (wgid % nig) / gsz; return true;
    }
    __device__ __forceinline__ void a_ready(const Unit&) const {}
    __device__ __forceinline__ void done(const Unit&) const {}
};
__device__ __forceinline__ unsigned cvt_pk_bf16(float lo, float hi) { unsigned r; asm volatile("v_cvt_pk_bf16_f32 %0, %1, %2" : "=v"(r) : "v"(lo), "v"(hi)); return r; }
typedef float f32x2 __attribute__((ext_vector_type(2)));

struct Gemm { const bf16_t* A; const bf16_t* Bt; int M, N, K, lda, ldb, bdil; };

__device__ __forceinline__ unsigned b_half_off(const Gemm& g, int pn, int h) {
    const int p0 = pn * BM + h * HALF; int row = p0;
    if (g.bdil != 1) { const int L = 2048 / g.bdil, b = p0 >> 11, pp = p0 & 2047, r = pp / L, u0 = pp - r * L; row = (b << 11) + u0 * g.bdil + r; }
    return (unsigned)row * (unsigned)g.ldb * 2u;
}

__device__ __forceinline__ f32x4 silu4(f32x4 v) {
    f32x4 o;
#pragma unroll
    for (int i = 0; i < 4; ++i) { const float e = __builtin_amdgcn_exp2f(v[i] * -1.4426950408889634f); o[i] = v[i] * __builtin_amdgcn_rcpf(1.0f + e); }
    return o;
}

struct EpiX {
    static constexpr bool PERM = true;
    int mode; bf16_t* O; int ldc; bf16_t* O2; const float* rope; float qscale;
    __device__ __forceinline__ static void store8(bf16_t* p, const f32x4 v0, const f32x4 v1) {
        u32x4 w; w.x = cvt_pk_bf16(v0[0], v0[1]); w.y = cvt_pk_bf16(v0[2], v0[3]); w.z = cvt_pk_bf16(v1[0], v1[1]); w.w = cvt_pk_bf16(v1[2], v1[3]); *(u32x4*)p = w; }
    __device__ __forceinline__ void operator()(const f32x4 (&acc)[2][2][4][2], const Unit& u, int wr, int wc, int fr, int fq) const {
        const int row0 = u.pm * BM + wr * 64 + fr;
        const bool pair = (mode == 1) || (mode == 2 && u.pn >= 4);
        if (pair) {
            bf16_t* base = (mode == 1) ? O : O2; const int pnn = (mode == 1) ? u.pn : u.pn - 4; const int ld = (mode == 1) ? ldc : 1024;
            const int col0 = pnn * HALF + wc * 32 + 8 * fq;
#pragma unroll
            for (int ai = 0; ai < 2; ++ai)
#pragma unroll
                for (int m = 0; m < 4; ++m) { bf16_t* rowp = base + (size_t)(row0 + ai * HALF + m * 16) * ld + col0;
                    f32x4 a0 = acc[ai][0][m][0], a1 = acc[ai][0][m][1]; const f32x4 b0 = acc[ai][1][m][0], b1 = acc[ai][1][m][1];
                    if (mode == 1) { a0 = silu4(a0); a1 = silu4(a1); }
                    store8(rowp, a0 * b0, a1 * b1); }
        } else {
            const int col0 = u.pn * BM + wc * 32 + 8 * fq;
            float sc = 1.f; bool dorope = false;
            if (mode == 3) { if (u.pn < 4) sc = qscale; dorope = ((wc & 1) == 0); }
            if (mode == 4) { if (u.pn < 2) sc = qscale; }
#pragma unroll
            for (int ai = 0; ai < 2; ++ai)
#pragma unroll
                for (int m = 0; m < 4; ++m) { const int row = row0 + ai * HALF + m * 16; bf16_t* rowp = O + (size_t)row * ldc + col0;
                    f32x4 c0 = (f32x4){1.f, 1.f, 1.f, 1.f}, c1 = c0, s0 = (f32x4){0.f, 0.f, 0.f, 0.f}, s1 = s0;
                    if (dorope) { const float* tp = rope + (size_t)(row & 2047) * 16; c0 = *(const f32x4*)(tp); c1 = *(const f32x4*)(tp + 4); s0 = *(const f32x4*)(tp + 8); s1 = *(const f32x4*)(tp + 12);
                        if (fq == 0) { s0 = -s0; s1 = -s1; } }
#pragma unroll
                    for (int bj = 0; bj < 2; ++bj) { f32x4 v0 = acc[ai][bj][m][0], v1 = acc[ai][bj][m][1];
                        if (dorope) { f32x4 p0, p1;
#pragma unroll
                            for (int e = 0; e < 4; ++e) { p0[e] = __shfl_xor(v0[e], 16); p1[e] = __shfl_xor(v1[e], 16); }
                            if (fq < 2) { v0 = v0 * c0 + p0 * s0; v1 = v1 * c1 + p1 * s1; } }
                        v0 = v0 * sc; v1 = v1 * sc; store8(rowp + bj * HALF, v0, v1); } }
        }
    }
};

template <class Epi, class Sched>
__device__ __forceinline__ void gemm_phase(PG8_LAS unsigned char* lds, const Gemm g, const Sched& S, const Epi& E) {
    int tid = threadIdx.x; asm volatile("" : "+v"(tid));
    const int wid = __builtin_amdgcn_readfirstlane(tid >> 6), lane = tid & 63, wr = wid >> 2, wc = wid & 3, fr = lane & 15, fq = lane >> 4;
    const int K = g.K, nt = K / BK;
    unsigned voffA[2], voffB[2];
#pragma unroll
    for (int i = 0; i < 2; ++i) { int R, C; stage_rc(tid * 16 + i * 8192, R, C); const int Rb = Epi::PERM ? ((R & ~31) + perm32(R & 31)) : R;
        voffA[i] = (unsigned)(R * g.lda + C) * 2u; voffB[i] = (unsigned)(Rb * g.bdil * g.ldb + C) * 2u; }
    const unsigned kstep = (unsigned)(BK * 2);
    const unsigned hstepA = (unsigned)HALF * (unsigned)g.lda * 2u;
    const unsigned tstepA = 2u * hstepA;
    const char* const baseA = (const char*)g.A; const char* const baseB = (const char*)g.Bt;
    const unsigned ldsw = (unsigned)wid * 1024u;
    const int aoff = lds_byte(wr * 64 + fr, fq * 8), boff = lds_byte(wc * 32 + fr, fq * 8);
#define PG8_SA(b, h) (((b) * 2 + (h)) * HTB)
#define PG8_SB(b, h) ((4 + (b) * 2 + (h)) * HTB)
#define PG8_STAGE(bufoff, gbase, uoff, voff) do { _Pragma("unroll") for (int _i = 0; _i < 2; ++_i) \
        __builtin_amdgcn_global_load_lds((const unsigned*)((gbase) + (size_t)((unsigned)(uoff) + (voff)[_i])), (PG8_LAS unsigned*)(lds + (bufoff) + ldsw + _i * 8192), 16, 0, 0); } while (0)
#define PG8_LDA(dst, b, h) do { _Pragma("unroll") for (int m = 0; m < 4; ++m) _Pragma("unroll") for (int k = 0; k < 2; ++k) dst[m][k] = *(const PG8_LAS bf16x8*)(lds + PG8_SA(b, h) + aoff + m * 2048 + k * 1024); } while (0)
#define PG8_LDB(dst, b, h) do { _Pragma("unroll") for (int n = 0; n < 2; ++n) _Pragma("unroll") for (int k = 0; k < 2; ++k) dst[n][k] = *(const PG8_LAS bf16x8*)(lds + PG8_SB(b, h) + boff + n * 2048 + k * 1024); } while (0)
#define PG8_MMA(ai, bj, At, Bt) do { __builtin_amdgcn_s_setprio(1); _Pragma("unroll") for (int m = 0; m < 4; ++m) _Pragma("unroll") for (int n = 0; n < 2; ++n) _Pragma("unroll") for (int k = 0; k < 2; ++k) \
        acc[ai][bj][m][n] = __builtin_amdgcn_mfma_f32_16x16x32_bf16(Bt[n][k], At[m][k], acc[ai][bj][m][n], 0, 0, 0); __builtin_amdgcn_s_setprio(0); } while (0)
#define PG8_WAIT_V(n) asm volatile("s_waitcnt vmcnt(" #n ")" ::: "memory")
#define PG8_WAIT_L(n) asm volatile("s_waitcnt lgkmcnt(" #n ")" ::: "memory")
#define PG8_BAR __builtin_amdgcn_s_barrier()
#define PG8_SCHED __builtin_amdgcn_sched_barrier(0)
    Unit cur, nxt; int ui = 0;
    if (!S.next(0, cur)) return;
    f32x4 acc[2][2][4][2];
#pragma unroll
    for (int a = 0; a < 2; ++a)
#pragma unroll
        for (int b = 0; b < 2; ++b)
#pragma unroll
            for (int m = 0; m < 4; ++m)
#pragma unroll
                for (int n = 0; n < 2; ++n) acc[a][b][m][n] = (f32x4){0.f, 0.f, 0.f, 0.f};
    bf16x8 At[4][2], B0[2][2], B1[2][2];
    unsigned cA = (unsigned)cur.pm * tstepA, cB0 = b_half_off(g, cur.pn, 0), cB1 = b_half_off(g, cur.pn, 1);
    PG8_STAGE(PG8_SB(0, 0), baseB, cB0, voffB); PG8_STAGE(PG8_SB(0, 1), baseB, cB1, voffB); PG8_STAGE(PG8_SA(0, 0), baseA, cA, voffA); PG8_STAGE(PG8_SA(0, 1), baseA, cA + hstepA, voffA);
    if (wr == 1) PG8_BAR;
    PG8_WAIT_V(2); PG8_BAR;
    PG8_STAGE(PG8_SB(1, 0), baseB, cB0 + kstep, voffB); PG8_STAGE(PG8_SA(1, 0), baseA, cA + kstep, voffA); PG8_STAGE(PG8_SB(1, 1), baseB, cB1 + kstep, voffB);
    PG8_WAIT_V(6); PG8_BAR;
    for (;;) {
        const bool has_next = S.next(ui + 1, nxt);
        const unsigned nA = has_next ? (unsigned)nxt.pm * tstepA : cA;
        const unsigned nB0 = has_next ? b_half_off(g, nxt.pn, 0) : cB0, nB1 = has_next ? b_half_off(g, nxt.pn, 1) : cB1;
        for (int t = 0; t < nt; t += 2) {
            const bool last = (t == nt - 2);
            const unsigned a1 = cA + (unsigned)(t + 1) * kstep;
            const unsigned a2 = last ? nA : cA + (unsigned)(t + 2) * kstep;
            const unsigned b2_0 = last ? nB0 : cB0 + (unsigned)(t + 2) * kstep, b2_1 = last ? nB1 : cB1 + (unsigned)(t + 2) * kstep;
            const unsigned a3 = a2 + kstep, b3_0 = b2_0 + kstep, b3_1 = b2_1 + kstep;
            PG8_LDB(B0, 0, 0); PG8_LDB(B1, 0, 1); PG8_SCHED; PG8_LDA(At, 0, 0); PG8_STAGE(PG8_SA(1, 1), baseA, a1 + hstepA, voffA);
            PG8_WAIT_V(8); PG8_WAIT_L(0); PG8_BAR; PG8_MMA(0, 0, At, B0); PG8_MMA(0, 1, At, B1); PG8_BAR; PG8_SCHED;
            PG8_LDA(At, 0, 1); PG8_STAGE(PG8_SB(0, 0), baseB, b2_0, voffB); PG8_STAGE(PG8_SB(0, 1), baseB, b2_1, voffB); PG8_STAGE(PG8_SA(0, 0), baseA, a2, voffA);
            PG8_WAIT_V(8); PG8_WAIT_L(0); PG8_BAR; PG8_MMA(1, 0, At, B0); PG8_MMA(1, 1, At, B1); PG8_BAR; PG8_SCHED;
            PG8_LDB(B0, 1, 0); PG8_LDB(B1, 1, 1); PG8_SCHED; PG8_LDA(At, 1, 0); PG8_STAGE(PG8_SA(0, 1), baseA, a2 + hstepA, voffA);
            PG8_WAIT_V(8); PG8_WAIT_L(0); PG8_BAR; PG8_MMA(0, 0, At, B0); PG8_MMA(0, 1, At, B1); PG8_BAR; PG8_SCHED;
            PG8_LDA(At, 1, 1); PG8_STAGE(PG8_SB(1, 0), baseB, b3_0, voffB); PG8_STAGE(PG8_SB(1, 1), baseB, b3_1, voffB); PG8_STAGE(PG8_SA(1, 0), baseA, a3, voffA);
            PG8_WAIT_V(8); PG8_WAIT_L(0); PG8_BAR; PG8_MMA(1, 0, At, B0); PG8_MMA(1, 1, At, B1); PG8_BAR; PG8_SCHED;
        }
        if (wr == 0) PG8_BAR;
        E(acc, cur, wr, wc, fr, fq);
        if (!has_next) break;
#pragma unroll
        for (int a = 0; a < 2; ++a)
#pragma unroll
            for (int b = 0; b < 2; ++b)
#pragma unroll
                for (int m = 0; m < 4; ++m)
#pragma unroll
                    for (int n = 0; n < 2; ++n) acc[a][b][m][n] = (f32x4){0.f, 0.f, 0.f, 0.f};
        cur = nxt; cA = nA; cB0 = nB0; cB1 = nB1; ++ui;
        if (wr == 1) PG8_BAR;
    }
    PG8_WAIT_V(0);
    PG8_BAR;
#undef PG8_SA
#undef PG8_SB
#undef PG8_STAGE
#undef PG8_LDA
#undef PG8_LDB
#undef PG8_MMA
#undef PG8_WAIT_V
#undef PG8_WAIT_L
#undef PG8_BAR
#undef PG8_SCHED
}
}
#define GAS __attribute__((address_space(1)))
#define LAS __attribute__((address_space(3)))
typedef unsigned short bf16;
typedef unsigned v4u __attribute__((ext_vector_type(4)));
typedef float f32x4 __attribute__((ext_vector_type(4)));
typedef short bf16x8 __attribute__((ext_vector_type(8)));
typedef GAS unsigned gu32;
typedef GAS unsigned long long gu64;
#define RLX_AGENT __ATOMIC_RELAXED, __HIP_MEMORY_SCOPE_AGENT
#define LDS_WAIT() asm volatile("s_waitcnt lgkmcnt(0)" ::: "memory")
#define VM_WAIT() asm volatile("s_waitcnt vmcnt(0)" ::: "memory")
__device__ __forceinline__ unsigned long long rt() { return __builtin_amdgcn_s_memrealtime(); }
__device__ __forceinline__ unsigned f2bf(float f) { unsigned u = __builtin_bit_cast(unsigned, f); return (u + 0x7fffu + ((u >> 16) & 1u)) >> 16; }
__device__ __forceinline__ unsigned pk2(float lo, float hi) { return f2bf(lo) | (f2bf(hi) << 16); }

#define XB_TMO      128
#define XB_XCNT(j)  (256  + 64 * (j))
#define XB_XSUB(j)  (1280 + 64 * (j))
#define XB_XGEN(j)  (2304 + 64 * (j))
#define XB_TOP      3328
#define XB_TOPGEN   3392
#define XCD_BAR_WORDS 3456
#define XB_SPIN_CAP (1u << 18)

__device__ __forceinline__ unsigned xb_ld(unsigned* p)              { return __hip_atomic_load(p, __ATOMIC_RELAXED, __HIP_MEMORY_SCOPE_AGENT); }
__device__ __forceinline__ unsigned xb_add(unsigned* p, unsigned v) { return __hip_atomic_fetch_add(p, v, __ATOMIC_RELAXED, __HIP_MEMORY_SCOPE_AGENT); }
__device__ __forceinline__ unsigned xb_xcc_id() { return (unsigned)__builtin_amdgcn_s_getreg((3 << 11) | 20) & 0xFu; }
#define XB_SPIN(cond, bar) do { unsigned _sp = 0; while (cond) { __builtin_amdgcn_s_sleep(1); \
    if ((++_sp & 255u) == 0u) { if (xb_ld(&(bar)[XB_TMO])) break; if (_sp > XB_SPIN_CAP) { atomicAdd(&(bar)[XB_TMO], 1u); break; } } } } while (0)

struct XcdBarrier {
    unsigned* bar; unsigned x;
    volatile LAS unsigned* st;
};

__device__ __forceinline__ XcdBarrier xcd_barrier_post(unsigned* bar, volatile LAS unsigned* st) {
    XcdBarrier b; b.bar = bar; b.x = xb_xcc_id(); b.st = st;
    if (threadIdx.x == 0) (void)xb_add(&bar[XB_XCNT(b.x)], 1u);
    return b;
}
__device__ __forceinline__ void xcd_barrier_complete(unsigned* bar, unsigned x, unsigned& nloc, unsigned& nx) {
    const unsigned G = gridDim.x * gridDim.y * gridDim.z;
    unsigned sum, cnt, mine, sp = 0u;
    for (;;) {
        sum = 0u; cnt = 0u; mine = 0u;
#pragma unroll
        for (unsigned j = 0; j < 16; ++j) { const unsigned c = xb_ld(&bar[XB_XCNT(j)]); sum += c; cnt += (c > 0u) ? 1u : 0u; mine = (j == x) ? c : mine; }
        if (sum == G) break;
        __builtin_amdgcn_s_sleep(1);
        if ((++sp & 255u) == 0u) { if (xb_ld(&bar[XB_TMO])) break; if (sp > XB_SPIN_CAP) { atomicAdd(&bar[XB_TMO], 1u); break; } }
    }
    nloc = mine > 0u ? mine : 1u; nx = cnt > 0u ? cnt : 1u;
}

__device__ __forceinline__ void xcd_barrier(const XcdBarrier& b) {
    asm volatile("s_waitcnt vmcnt(0)" ::: "memory");
    __syncthreads();
    if (threadIdx.x == 0) {
        unsigned* bar = b.bar;
        __builtin_amdgcn_s_waitcnt(0);
        unsigned nloc = b.st[0], nx = b.st[1];
        if (nloc == 0u) { xcd_barrier_complete(bar, b.x, nloc, nx); b.st[0] = nloc; b.st[1] = nx; }
        const unsigned old = xb_add(&bar[XB_XSUB(b.x)], 1u);
        const unsigned gen = old / nloc;
        if (old + 1u == (gen + 1u) * nloc) {
            __builtin_amdgcn_fence(__ATOMIC_RELEASE, "agent");
            asm volatile("s_waitcnt vmcnt(0)" ::: "memory");
            const unsigned og = xb_add(&bar[XB_TOP], 1u);
            const unsigned tg = og / nx;
            if (og + 1u == (tg + 1u) * nx) xb_add(&bar[XB_TOPGEN], 1u);
            else XB_SPIN(xb_ld(&bar[XB_TOPGEN]) == tg, bar);
            __builtin_amdgcn_fence(__ATOMIC_ACQUIRE, "agent");
            xb_add(&bar[XB_XGEN(b.x)], 1u);
            asm volatile("s_waitcnt vmcnt(0)" ::: "memory");
        } else {
            XB_SPIN(xb_ld(&bar[XB_XGEN(b.x)]) == gen, bar);
            __builtin_amdgcn_fence(__ATOMIC_ACQUIRE, "agent");
            asm volatile("s_waitcnt vmcnt(0)" ::: "memory");
        }
    }
    __syncthreads();
}

constexpr int NWAVES = 8;
constexpr int BATCH = 8, SEQ = 2048, D = 1024, FF = 2816, DEPTH = 4;
constexpr int M = BATCH * SEQ;
constexpr float EPS = 1e-6f;
constexpr int ML_PROJ = 3080;
constexpr float ATT_QSCALE = 0.125f * 1.4426950408889634f;
constexpr float ML_QSCALE = 0.08838834764831845f;

constexpr size_t MiB = 1u << 20;
constexpr size_t WS_CTL = 0, CTL_ZERO_BYTES = 1 * MiB;
constexpr size_t WS_ROPE = 1 * MiB;
constexpr size_t WS_GATEW = WS_ROPE + 256 * 1024;
constexpr size_t WS_GATES = WS_ROPE + 512 * 1024;
constexpr size_t WS_LSE = 2 * MiB;
constexpr size_t WS_NST = 3 * MiB;
constexpr size_t WS_MST = 3 * MiB + 512 * 1024;
constexpr size_t WS_WUP = 8 * MiB;
constexpr size_t WS_WDN = 96 * MiB;
constexpr size_t WS_WCIN = 140 * MiB;
constexpr size_t WS_WCOUT = 152 * MiB;
constexpr size_t WS_WAIN = 156 * MiB;
constexpr size_t WS_WAOUT = 174 * MiB;
constexpr size_t WS_WMIN = 176 * MiB;
constexpr size_t WS_WMOUT = 183 * MiB;
constexpr size_t WS_XN = 186 * MiB;
constexpr size_t WS_BIG = 218 * MiB;
constexpr size_t WS_Y = WS_BIG + 88 * MiB;
constexpr size_t WS_R2 = 338 * MiB;
constexpr size_t WS_END = 402 * MiB;
constexpr int CW_BAR = 4096;

constexpr int RING_OFF = 0, RING_BYTES = 131072;
constexpr int LDS_BYTES = 147456;
constexpr int MISC_OFF = LDS_BYTES - 512;

struct Args { const float* in[17]; float* out; unsigned char* ws; int ph_lo, ph_hi; };

struct Frame {
    LAS unsigned char* lds;
    volatile LAS unsigned* MISC;
    gu32* ctl;
    int vcu, G;
    unsigned char* ws;
};
struct LaneId { int tid, lane, wave; };
__device__ __forceinline__ LaneId lane_id() { int t = threadIdx.x; asm volatile("" : "+v"(t)); LaneId L; L.tid = t; L.lane = t & 63; L.wave = __builtin_amdgcn_readfirstlane(t >> 6); return L; }

__device__ __forceinline__ float wave_sum(float v) {
#pragma unroll
    for (int o = 1; o < 64; o <<= 1) v += __shfl_xor(v, o);
    return v;
}
__device__ __forceinline__ float wave_max(float v) {
#pragma unroll
    for (int o = 1; o < 64; o <<= 1) v = fmaxf(v, __shfl_xor(v, o));
    return v;
}
__device__ __forceinline__ float wave_incl_sum(float v, int lane) {
#pragma unroll
    for (int o = 1; o < 64; o <<= 1) { const float t = __shfl_up(v, o); if (lane >= o) v += t; }
    return v;
}
__device__ __forceinline__ float wave_incl_max(float v, int lane) {
#pragma unroll
    for (int o = 1; o < 64; o <<= 1) { const float t = __shfl_up(v, o); if (lane >= o) v = fmaxf(v, t); }
    return v;
}
__device__ __forceinline__ float bflo(unsigned w) { return __uint_as_float(w << 16); }
__device__ __forceinline__ float bfhi(unsigned w) { return __uint_as_float(w & 0xffff0000u); }
__device__ __forceinline__ float bf2f(bf16 u) { return __uint_as_float((unsigned)u << 16); }
__device__ __forceinline__ float dot8(const v4u a, const v4u b, float acc) {
    acc += bflo(a.x) * bflo(b.x); acc += bfhi(a.x) * bfhi(b.x); acc += bflo(a.y) * bflo(b.y); acc += bfhi(a.y) * bfhi(b.y);
    acc += bflo(a.z) * bflo(b.z); acc += bfhi(a.z) * bfhi(b.z); acc += bflo(a.w) * bflo(b.w); acc += bfhi(a.w) * bfhi(b.w); return acc;
}
__device__ __forceinline__ float bfel(const v4u a, int i) { const unsigned w = a[i >> 1]; return (i & 1) ? bfhi(w) : bflo(w); }
__device__ __forceinline__ float ld_f32_coherent(const float* p) { return __uint_as_float(__hip_atomic_load((const unsigned*)p, RLX_AGENT)); }
__device__ __forceinline__ float logsigmoid_f(float x) { return fminf(x, 0.f) - log1pf(expf(-fabsf(x))); }

__device__ __forceinline__ void thin_phase(Frame& F, const float* xsrc, float* xdst, const bf16* y, const float* gpost, float pscale, const float* gpre, bf16* xn, const float* gatew, float* gates) {
    const LaneId li = lane_id(); const int gw = F.vcu * NWAVES + li.wave, NGW = F.G * NWAVES, lane = li.lane;
    f32x4 gp[4], gq[4];
#pragma unroll
    for (int i = 0; i < 4; ++i) { const int col = 512 * (i >> 1) + 8 * lane + 4 * (i & 1);
        gp[i] = gpost ? *(const f32x4*)(gpost + col) : (f32x4){0.f, 0.f, 0.f, 0.f}; gq[i] = gpre ? *(const f32x4*)(gpre + col) : (f32x4){0.f, 0.f, 0.f, 0.f}; }
    for (int m = gw; m < M; m += NGW) {
        f32x4 xv[4];
#pragma unroll
        for (int i = 0; i < 4; ++i) xv[i] = *(const GAS f32x4*)(xsrc + (size_t)m * D + 512 * (i >> 1) + 8 * lane + 4 * (i & 1));
        if (y) {
            f32x4 yf[4]; float ssq = 0.f;
#pragma unroll
            for (int j = 0; j < 2; ++j) { const v4u w = *(const GAS v4u*)(y + (size_t)m * D + 512 * j + 8 * lane);
                yf[2 * j] = (f32x4){bflo(w.x), bfhi(w.x), bflo(w.y), bfhi(w.y)}; yf[2 * j + 1] = (f32x4){bflo(w.z), bfhi(w.z), bflo(w.w), bfhi(w.w)}; }
#pragma unroll
            for (int i = 0; i < 4; ++i) ssq += (yf[i].x * yf[i].x + yf[i].y * yf[i].y) + (yf[i].z * yf[i].z + yf[i].w * yf[i].w);
            const float r1 = pscale / sqrtf(wave_sum(ssq) * (1.f / D) + EPS);
#pragma unroll
            for (int i = 0; i < 4; ++i) xv[i] = xv[i] + yf[i] * gp[i] * r1;
        }
#pragma unroll
        for (int i = 0; i < 4; ++i) *(GAS f32x4*)(xdst + (size_t)m * D + 512 * (i >> 1) + 8 * lane + 4 * (i & 1)) = xv[i];
        if (gpre) {
            float ssq = 0.f;
#pragma unroll
            for (int i = 0; i < 4; ++i) ssq += (xv[i].x * xv[i].x + xv[i].y * xv[i].y) + (xv[i].z * xv[i].z + xv[i].w * xv[i].w);
            const float r2 = 1.f / sqrtf(wave_sum(ssq) * (1.f / D) + EPS);
            f32x4 o[4];
#pragma unroll
            for (int i = 0; i < 4; ++i) o[i] = xv[i] * gq[i] * r2;
#pragma unroll
            for (int j = 0; j < 2; ++j) { v4u w; w.x = pk2(o[2 * j].x, o[2 * j].y); w.y = pk2(o[2 * j].z, o[2 * j].w); w.z = pk2(o[2 * j + 1].x, o[2 * j + 1].y); w.w = pk2(o[2 * j + 1].z, o[2 * j + 1].w);
                *(GAS v4u*)(xn + (size_t)m * D + 512 * j + 8 * lane) = w; }
            if (gatew) {
                float mine = 0.f;
#pragma unroll
                for (int jg = 0; jg < 8; ++jg) { float s = 0.f;
#pragma unroll
                    for (int i = 0; i < 4; ++i) { const f32x4 wv = *(const GAS f32x4*)(gatew + jg * D + 512 * (i >> 1) + 8 * lane + 4 * (i & 1)); s += (o[i].x * wv.x + o[i].y * wv.y) + (o[i].z * wv.z + o[i].w * wv.w); }
                    s = wave_sum(s); if (lane == jg) mine = s; }
                if (lane < 8) gates[(size_t)m * 8 + lane] = mine;
            }
        }
    }
}

__device__ __forceinline__ void conv_phase(Frame& F, bf16* Bz, const bf16* CU, const float* ck) {
    const LaneId li = lane_id(); const int gw = F.vcu * NWAVES + li.wave, NGW = F.G * NWAVES, lane = li.lane;
    f32x4 kk[3][4];
#pragma unroll
    for (int l = 0; l < 3; ++l)
#pragma unroll
        for (int i = 0; i < 4; ++i) kk[l][i] = *(const f32x4*)(ck + l * D + 512 * (i >> 1) + 8 * lane + 4 * (i & 1));
    for (int m = gw; m < M; m += NGW) {
        const int t = m & (SEQ - 1);
#pragma unroll
        for (int j = 0; j < 2; ++j) {
            const size_t off = (size_t)m * D + 512 * j + 8 * lane;
            const v4u bw = *(const GAS v4u*)(Bz + off); const v4u c0 = *(const GAS v4u*)(CU + off);
            v4u c1 = (v4u){0u, 0u, 0u, 0u}, c2 = c1;
            if (t >= 1) c1 = *(const GAS v4u*)(CU + off - D);
            if (t >= 2) c2 = *(const GAS v4u*)(CU + off - 2 * D);
            float z[8];
#pragma unroll
            for (int e = 0; e < 8; ++e) { const f32x4 k0 = kk[0][2 * j + (e >> 2)], k1 = kk[1][2 * j + (e >> 2)], k2 = kk[2][2 * j + (e >> 2)];
                z[e] = bfel(bw, e) * (k0[e & 3] * bfel(c0, e) + k1[e & 3] * bfel(c1, e) + k2[e & 3] * bfel(c2, e)); }
            v4u w; w.x = pk2(z[0], z[1]); w.y = pk2(z[2], z[3]); w.z = pk2(z[4], z[5]); w.w = pk2(z[6], z[7]);
            *(GAS v4u*)(Bz + off) = w;
        }
    }
}

__device__ __forceinline__ void transpose_tile(const float* src, int ld, int k0, int n0, bf16* dst, int Kd, LAS float* scr, int lane) {
#pragma unroll 4
    for (int i = 0; i < 16; ++i) { const int kk = 4 * i + (lane >> 4), c4 = (lane & 15) * 4;
        const f32x4 v = *(const f32x4*)(src + (size_t)(k0 + kk) * ld + n0 + c4);
        scr[kk * 65 + c4 + 0] = v.x; scr[kk * 65 + c4 + 1] = v.y; scr[kk * 65 + c4 + 2] = v.z; scr[kk * 65 + c4 + 3] = v.w; }
    LDS_WAIT(); asm volatile("" ::: "memory");
    const int c = lane & 7;
#pragma unroll
    for (int j = 0; j < 8; ++j) { const int n = (lane >> 3) + 8 * j; const LAS float* s = scr + (8 * c) * 65 + n;
        v4u o; o.x = pk2(s[0 * 65], s[1 * 65]); o.y = pk2(s[2 * 65], s[3 * 65]); o.z = pk2(s[4 * 65], s[5 * 65]); o.w = pk2(s[6 * 65], s[7 * 65]);
        *(GAS v4u*)(dst + (size_t)n * Kd + k0 + 8 * c) = o; }
    LDS_WAIT(); asm volatile("" ::: "memory");
}

__device__ __forceinline__ void prologue(Frame& F, const Args& a) {
    const LaneId li = lane_id();
    LAS float* scr = (LAS float*)(F.lds + li.wave * 16640);
    const int gw = F.vcu * NWAVES + li.wave, NGW = F.G * NWAVES, lane = li.lane;
    unsigned char* ws = F.ws;
    constexpr int N_UP = 16 * 704, N_DN = 8 * 704, N_CIN = 2 * 768, N_COUT = 2 * 256, N_AIN = 2304, N_AOUT = 256, N_MIN = 896, N_MOUT = 256;
    constexpr int N_ITEMS = N_UP + N_DN + N_CIN + N_COUT + N_AIN + N_AOUT + N_MIN + N_MOUT;
    for (int it = gw; it < N_ITEMS; it += NGW) {
        int r = it; const float* src; int ld, K, kb, n0; bf16* dst;
        if (r < N_UP) { const int mtx = r / 704; r -= mtx * 704; const int l = mtx >> 2, f = (mtx >> 1) & 1, which = mtx & 1;
            src = a.in[2 + 3 * f + which] + (size_t)l * D * FF; ld = FF; K = D; kb = r / 44; n0 = (r - kb * 44) * 64;
            dst = (bf16*)(ws + WS_WUP) + (size_t)(l * 2 + f) * (2 * FF) * D + (size_t)(256 * (n0 >> 7) + (n0 & 127) + which * 128) * D; }
        else if ((r -= N_UP) < N_DN) { const int mtx = r / 704; r -= mtx * 704; const int l = mtx >> 1, f = mtx & 1;
            src = a.in[4 + 3 * f] + (size_t)l * FF * D; ld = D; K = FF; kb = r >> 4; n0 = (r & 15) * 64;
            dst = (bf16*)(ws + WS_WDN) + (size_t)(l * 2 + f) * D * FF + (size_t)n0 * FF; }
        else if ((r -= N_DN) < N_CIN) { const int j = r / 768; r -= j * 768;
            src = a.in[8] + (size_t)j * D * 3072; ld = 3072; K = D; kb = r / 48; n0 = (r - kb * 48) * 64;
            int drow = n0; if (n0 >= 2048) { const int f = n0 - 2048; drow = 1024 + 256 * (f >> 7) + 128 + (f & 127); } else if (n0 >= 1024) { const int f = n0 - 1024; drow = 1024 + 256 * (f >> 7) + (f & 127); }
            dst = (bf16*)(ws + WS_WCIN) + (size_t)j * 3072 * D + (size_t)drow * D; }
        else if ((r -= N_CIN) < N_COUT) { const int j = r >> 8; r &= 255;
            src = a.in[10] + (size_t)j * D * D; ld = D; K = D; kb = r >> 4; n0 = (r & 15) * 64;
            dst = (bf16*)(ws + WS_WCOUT) + (size_t)j * D * D + (size_t)n0 * D; }
        else if ((r -= N_COUT) < N_AIN) { src = a.in[11]; ld = 9216; K = D; kb = r / 144; n0 = (r - kb * 144) * 64;
            dst = (bf16*)(ws + WS_WAIN) + (size_t)n0 * D; }
        else if ((r -= N_AIN) < N_AOUT) { src = a.in[12]; ld = D; K = D; kb = r >> 4; n0 = (r & 15) * 64;
            dst = (bf16*)(ws + WS_WAOUT) + (size_t)n0 * D; }
        else if ((r -= N_AOUT) < N_MIN) { src = a.in[13]; ld = ML_PROJ; K = D; kb = r / 56; const int gi = r - kb * 56; int drow;
            if (gi < 16) { n0 = gi * 64; drow = n0; }
            else if (gi < 32) { n0 = 2048 + (gi - 16) * 64; drow = 1024 + (gi - 16) * 64; }
            else if (gi < 40) { n0 = 512 + (gi - 32) * 64; drow = 2048 + (gi - 32) * 64; }
            else { n0 = 1024 + (gi - 40) * 64; drow = 2560 + (gi - 40) * 64; }
            dst = (bf16*)(ws + WS_WMIN) + (size_t)drow * D; }
        else { r -= N_MIN; src = a.in[16]; ld = D; K = D; kb = r >> 4; n0 = (r & 15) * 64;
            dst = (bf16*)(ws + WS_WMOUT) + (size_t)n0 * D; }
        transpose_tile(src, ld, kb * 64, n0, dst, K, scr, lane);
    }
    { const int gt = gw * 64 + lane;
      if (gt < SEQ * 8) { const int t = gt >> 3, i = gt & 7; const float inv = (float)exp(-((double)i / 8.0) * log(500000.0)); const float ang = (float)t * inv;
          float* tab = (float*)(ws + WS_ROPE); tab[t * 16 + i] = (float)cos((double)ang); tab[t * 16 + 8 + i] = (float)sin((double)ang); }
      if (gt < 8 * D) { const int j = gt >> 10, k = gt & 1023; ((float*)(ws + WS_GATEW))[gt] = a.in[13][(size_t)k * ML_PROJ + 3072 + j]; } }
    thin_phase(F, a.in[0], a.out, nullptr, nullptr, 0.f, a.in[1], (bf16*)(ws + WS_XN), nullptr, nullptr);
}

__device__ __forceinline__ void attn_naive(Frame& F, int g) {
    const int sh = 2 * g, dil = 1 << sh, L = SEQ >> sh;
    const bf16* QK = (const bf16*)(F.ws + WS_BIG); const bf16* VT = QK + (size_t)M * 2048;
    bf16* OACC = (bf16*)(F.ws + WS_R2); float* LSE = (float*)(F.ws + WS_LSE);
    const LaneId li = lane_id();
    LAS float* pb = (LAS float*)(F.lds + li.wave * 1024);
    const int lane = li.lane, gw = F.vcu * NWAVES + li.wave, NGW = F.G * NWAVES;
    for (int task = gw; task < M * 16; task += NGW) {
        const int row = task >> 4, h = task & 15, b = row >> 11, t = row & (SEQ - 1), u = t >> sh, r = t & (dil - 1);
        const int nk = (u < 128 ? u : 128) + 1;
        const GAS v4u* qp = (const GAS v4u*)(QK + (size_t)row * 2048 + h * 64);
        v4u q[8];
#pragma unroll
        for (int i = 0; i < 8; ++i) q[i] = qp[i];
        float s[3];
#pragma unroll
        for (int jj = 0; jj < 3; ++jj) { const int j = lane + 64 * jj; float acc = -INFINITY;
            if (j < nk) { const int tj = ((u - j) << sh) + r; const GAS v4u* kp = (const GAS v4u*)(QK + (size_t)((b << 11) + tj) * 2048 + 1024 + h * 64); acc = 0.f;
#pragma unroll
                for (int i = 0; i < 8; ++i) acc = dot8(q[i], kp[i], acc); }
            s[jj] = acc; }
        const float mx = wave_max(fmaxf(s[0], fmaxf(s[1], s[2])));
        float p[3], ls = 0.f;
#pragma unroll
        for (int jj = 0; jj < 3; ++jj) { p[jj] = (lane + 64 * jj < nk) ? exp2f(s[jj] - mx) : 0.f; ls += p[jj]; }
        const float l = wave_sum(ls);
        pb[lane] = p[0]; pb[64 + lane] = p[1]; pb[128 + lane] = p[2];
        LDS_WAIT(); __builtin_amdgcn_wave_barrier();
        const GAS bf16* vp = (const GAS bf16*)VT + (size_t)(h * 64 + lane) * M + (b << 11) + r * L + u;
        float o = 0.f;
        for (int j = 0; j < nk; ++j) o += pb[j] * bf2f(vp[-j]);
        o /= l; float lse = mx + log2f(l);
        const size_t oi = (size_t)row * 1024 + h * 64 + lane;
        if (g > 0) { const float lp = ld_f32_coherent(LSE + (size_t)row * 16 + h); const float op = bf2f(((const GAS bf16*)OACC)[oi]);
            const float mm = fmaxf(lp, lse), e1 = exp2f(lp - mm), e2 = exp2f(lse - mm), den = e1 + e2; o = (op * e1 + o * e2) / den; lse = mm + log2f(den); }
        ((GAS bf16*)OACC)[oi] = (bf16)f2bf(o); if (lane == 0) LSE[(size_t)row * 16 + h] = lse;
        LDS_WAIT(); __builtin_amdgcn_wave_barrier();
    }
}

__device__ __forceinline__ void mlstm_S_naive(Frame& F, const float* b_i, const float* b_f) {
    const bf16* KVT = (const bf16*)(F.ws + WS_BIG) + (size_t)M * 2048;
    bf16* CST = (bf16*)(F.ws + WS_R2); float* NST = (float*)(F.ws + WS_NST); float* MST = (float*)(F.ws + WS_MST); const float* GATES = (const float*)(F.ws + WS_GATES);
    const LaneId li = lane_id(); const int tid = li.tid, lane = li.lane, vl = tid >> 4, d0 = (tid & 15) * 8;
    for (int item = F.vcu; item < 256; item += F.G) {
        const int bh = item >> 3, strip = item & 7, b = bh >> 2, h = bh & 3;
        float C[8];
#pragma unroll
        for (int e = 0; e < 8; ++e) C[e] = 0.f;
        float nacc = 0.f, m_prev = 0.f;
        const float bi = b_i[h], bff = b_f[h];
        const GAS bf16* vT = (const GAS bf16*)KVT + (size_t)(512 + h * 256 + strip * 32 + vl) * M + (b << 11);
        const GAS bf16* kT = (const GAS bf16*)KVT + (size_t)(h * 128 + d0) * M + (b << 11);
        const GAS bf16* kTn = (const GAS bf16*)KVT + (size_t)(h * 128 + (tid & 127)) * M + (b << 11);
        for (int c = 0; c < 32; ++c) {
            const size_t sidx = (size_t)(bh * 32 + c);
            { v4u w; w.x = pk2(C[0], C[1]); w.y = pk2(C[2], C[3]); w.z = pk2(C[4], C[5]); w.w = pk2(C[6], C[7]);
              *(GAS v4u*)(CST + (sidx * 256 + strip * 32 + vl) * 128 + d0) = w; }
            if (strip == 0 && tid < 128) NST[sidx * 128 + tid] = nacc;
            if (strip == 0 && tid == 0) MST[sidx] = m_prev;
            const int tok = (b << 11) + c * 64 + lane;
            const float ig = GATES[(size_t)tok * 8 + h] + bi; const float lf = logsigmoid_f(GATES[(size_t)tok * 8 + 4 + h] + bff);
            const float bc = wave_incl_sum(lf, lane); const float btot = __shfl(bc, 63);
            const float amax = wave_max(ig - bc);
            const float m_new = btot + fmaxf(m_prev, amax);
            const float we = expf(btot - bc + ig - m_new); const float decay = expf(btot + m_prev - m_new);
#pragma unroll
            for (int e = 0; e < 8; ++e) C[e] *= decay;
            float nsum = 0.f;
            for (int s8 = 0; s8 < 8; ++s8) {
                const v4u vv = *(const GAS v4u*)(vT + c * 64 + s8 * 8); const v4u kn = *(const GAS v4u*)(kTn + c * 64 + s8 * 8);
                v4u kk[8];
#pragma unroll
                for (int e = 0; e < 8; ++e) kk[e] = *(const GAS v4u*)(kT + (size_t)e * M + c * 64 + s8 * 8);
#pragma unroll
                for (int i = 0; i < 8; ++i) { const float w = __shfl(we, s8 * 8 + i); const float vw = bfel(vv, i) * w;
#pragma unroll
                    for (int e = 0; e < 8; ++e) C[e] += vw * bfel(kk[e], i);
                    nsum += w * bfel(kn, i); }
            }
            nacc = decay * nacc + nsum;
            m_prev = m_new;
        }
    }
}

__device__ __forceinline__ void mlstm_O_naive(Frame& F, const float* b_i, const float* b_f) {
    const bf16* QKO = (const bf16*)(F.ws + WS_BIG); const bf16* KVT = QKO + (size_t)M * 2048;
    const bf16* CST = (const bf16*)(F.ws + WS_R2); const float* NST = (const float*)(F.ws + WS_NST); const float* MST = (const float*)(F.ws + WS_MST); const float* GATES = (const float*)(F.ws + WS_GATES);
    bf16* HOG = (bf16*)(F.ws + WS_XN);
    LAS float* A = (LAS float*)F.lds; LAS float* vb = (LAS float*)(F.lds + 17408);
    const LaneId li = lane_id(); const int tid = li.tid, lane = li.lane;
    for (int item = F.vcu; item < 1024; item += F.G) {
        const int bh = item >> 5, c = item & 31, b = bh >> 2, h = bh & 3; const int tok0 = (b << 11) + c * 64;
        if (li.wave == 0) { int ll = lane; asm volatile("" : "+v"(ll)); const int tok = tok0 + ll;
            const float ig = GATES[(size_t)tok * 8 + h] + b_i[h]; const float lf = logsigmoid_f(GATES[(size_t)tok * 8 + 4 + h] + b_f[h]);
            const float bc = wave_incl_sum(lf, ll); const float m_prev = ld_f32_coherent(MST + item);
            const float run = wave_incl_max(ig - bc, ll); const float mt = bc + fmaxf(m_prev, run); const float wi = expf(bc + m_prev - mt);
            vb[ll] = bc; vb[64 + ll] = ig; vb[128 + ll] = mt; vb[192 + ll] = wi; }
        __syncthreads();
        const int t = tid >> 3;
        const GAS v4u* qp = (const GAS v4u*)(QKO + (size_t)(tok0 + t) * 2048 + h * 128);
        { const int s0 = (tid & 7) * 8; const float bt = vb[t], mtt = vb[128 + t];
          v4u q[16];
#pragma unroll
          for (int i = 0; i < 16; ++i) q[i] = qp[i];
#pragma unroll 1
          for (int e = 0; e < 8; ++e) { const int s = s0 + e; float val = 0.f;
              if (s <= t) { const GAS v4u* kp = (const GAS v4u*)(QKO + (size_t)(tok0 + s) * 2048 + 512 + h * 128); float dt = 0.f;
#pragma unroll
                  for (int i = 0; i < 16; ++i) dt = dot8(q[i], kp[i], dt);
                  val = dt * expf(bt - vb[s] + vb[64 + s] - mtt); }
              A[t * 65 + s] = val; } }
        __syncthreads();
        { const int v0 = (tid & 7) * 32; const float mtt = vb[128 + t], wi = vb[192 + t];
          float den = 0.f;
#pragma unroll 4
          for (int s = 0; s < 64; ++s) den += A[t * 65 + s];
          float nq = 0.f;
          { const int part = tid & 7; const GAS f32x4* np = (const GAS f32x4*)(NST + (size_t)item * 128 + part * 16);
            const GAS v4u* qp2 = (const GAS v4u*)(QKO + (size_t)(tok0 + t) * 2048 + h * 128 + part * 16);
            const v4u qa = qp2[0], qb = qp2[1]; const f32x4 n0 = np[0], n1 = np[1], n2 = np[2], n3 = np[3];
            nq = n0.x * bflo(qa.x) + n0.y * bfhi(qa.x) + n0.z * bflo(qa.y) + n0.w * bfhi(qa.y) + n1.x * bflo(qa.z) + n1.y * bfhi(qa.z) + n1.z * bflo(qa.w) + n1.w * bfhi(qa.w)
               + n2.x * bflo(qb.x) + n2.y * bfhi(qb.x) + n2.z * bflo(qb.y) + n2.w * bfhi(qb.y) + n3.x * bflo(qb.z) + n3.y * bfhi(qb.z) + n3.z * bflo(qb.w) + n3.w * bfhi(qb.w);
            nq += __shfl_xor(nq, 1); nq += __shfl_xor(nq, 2); nq += __shfl_xor(nq, 4); }
          den += wi * nq; const float dn = fmaxf(fabsf(den), expf(-mtt));
#pragma unroll 1
          for (int vv = 0; vv < 32; ++vv) { const int v = v0 + vv;
              const GAS v4u* vtp = (const GAS v4u*)(KVT + (size_t)(512 + h * 256 + v) * M + tok0);
              float num = 0.f;
#pragma unroll
              for (int s8 = 0; s8 < 8; ++s8) { const v4u w = vtp[s8];
#pragma unroll
                  for (int i = 0; i < 8; ++i) num += A[t * 65 + s8 * 8 + i] * bfel(w, i); }
              const GAS v4u* cp = (const GAS v4u*)(CST + ((size_t)item * 256 + v) * 128);
              float cq = 0.f;
#pragma unroll 4
              for (int i = 0; i < 16; ++i) cq = dot8(cp[i], qp[i], cq);
              num += wi * cq;
              const float og = bf2f(((const GAS bf16*)QKO)[(size_t)(tok0 + t) * 2048 + 1024 + h * 256 + v]);
              const float outv = (num / dn) / (1.f + expf(-og));
              ((GAS bf16*)HOG)[(size_t)(tok0 + t) * 1024 + h * 256 + v] = (bf16)f2bf(outv); } }
        __syncthreads();
    }
}

#ifndef MK_SPLIT
#define MK_SPLIT 0
#endif
constexpr int N_PHASE_IDS = 1 + 8 * 12;
__host__ __device__ inline bool phase_nonempty(int id) {
    if (id == 0) return true;
    const int s = (id - 1) >> 3, k = (id - 1) & 7, sub = s % 3, mix = (s / 3) % 3;
    if (k >= 6) return true;
    if (sub != 1) return k == 0;
    if (mix == 0) return k <= 1;
    if (mix == 1) return k <= 5;
    return k <= 2;
}

__global__ void __launch_bounds__(NWAVES * 64, 2) mk_fwd(Args args) {
    extern __shared__ __attribute__((aligned(16))) unsigned char lds[];
    Frame F;
    F.lds = (LAS unsigned char*)lds;
    F.MISC = (volatile LAS unsigned*)(F.lds + MISC_OFF);
    F.G = gridDim.x; { const int bx = blockIdx.x; F.vcu = (F.G % 8 == 0) ? (bx % 8) * (F.G / 8) + bx / 8 : bx; }
    F.ws = args.ws; F.ctl = (gu32*)(args.ws + WS_CTL);
    unsigned char* ws = args.ws;
    for (int u = threadIdx.x; u < (LDS_BYTES - MISC_OFF) / 4; u += NWAVES * 64) ((LAS unsigned*)(F.lds + MISC_OFF))[u] = 0u;
    __syncthreads();
#if MK_SPLIT
    const int lo = args.ph_lo, hi = args.ph_hi;
    int pid = 0;
#define RUN(k) ((pid = (k)), (lo <= pid && pid < hi))
#define SEAM() do { } while (0)
#else
    (void)xcd_barrier_post((unsigned*)(F.ctl + CW_BAR), F.MISC + 8);
    int pid = 0;
#define RUN(k) ((pid = (k)), true)
#define SEAM() do { if (pid + 1 < N_PHASE_IDS) { XcdBarrier bar_; bar_.bar = (unsigned*)(F.ctl + CW_BAR); bar_.x = xb_xcc_id(); bar_.st = F.MISC + 8; xcd_barrier(bar_); } } while (0)
#endif

    bf16* const XN = (bf16*)(ws + WS_XN); bf16* const BIG = (bf16*)(ws + WS_BIG); bf16* const Y = (bf16*)(ws + WS_Y); bf16* const R2 = (bf16*)(ws + WS_R2);
    const float* const rope = (const float*)(ws + WS_ROPE);

    if (RUN(0)) { prologue(F, args); SEAM(); }

    for (int s = 0; s < 12; ++s) {
        const int layer = s / 3, sub = s - 3 * layer, mix = layer % 3, mj = layer / 3, base = 1 + 8 * s;
        const bool is_ffn = (sub != 1);
        const int nrep = (!is_ffn && mix == 1) ? 3 : 1;
        for (int rep = 0; rep < nrep; ++rep) {
            if (RUN(base + 2 * rep)) {
                {   pg8::Gemm g; pg8::EpiX E;
                    g.A = XN; g.M = M; g.K = D; g.lda = D; g.ldb = D; g.bdil = 1; E.O = BIG; E.O2 = nullptr; E.rope = rope; E.qscale = 1.f;
                    if (is_ffn) { g.Bt = (const bf16*)(ws + WS_WUP) + (size_t)(layer * 2 + (sub >> 1)) * (2 * FF) * D; g.N = 2 * FF; E.mode = 1; E.ldc = FF; }
                    else if (mix == 0) { g.Bt = (const bf16*)(ws + WS_WCIN) + (size_t)mj * 3072 * D; g.N = 3072; E.mode = 2; E.ldc = 1024; E.O2 = BIG + (size_t)M * 1024; }
                    else if (mix == 1) { g.Bt = (const bf16*)(ws + WS_WAIN) + (size_t)(rep * 3072) * D; g.N = 2048; E.mode = 3; E.ldc = 2048; E.qscale = ATT_QSCALE; }
                    else { g.Bt = (const bf16*)(ws + WS_WMIN); g.N = 2048; E.mode = 4; E.ldc = 2048; E.qscale = ML_QSCALE; }
                    pg8::StaticOrder S; S.init(g.M, g.N, F.G, (int)blockIdx.x); pg8::gemm_phase<pg8::EpiX, pg8::StaticOrder>(F.lds + RING_OFF, g, S, E); }
                if (!is_ffn && mix != 0) {
                    pg8::Gemm g; pg8::EpiX E;
                    g.Bt = XN; g.N = M; g.K = D; g.lda = D; g.ldb = D; E.mode = 0; E.O = BIG + (size_t)M * 2048; E.ldc = M; E.O2 = nullptr; E.rope = rope; E.qscale = 1.f;
                    if (mix == 1) { g.A = (const bf16*)(ws + WS_WAIN) + (size_t)(rep * 3072 + 2048) * D; g.M = 1024; g.bdil = 1 << (2 * rep); }
                    else { g.A = (const bf16*)(ws + WS_WMIN) + (size_t)2048 * D; g.M = 1536; g.bdil = 1; }
                    pg8::StaticOrder S; S.init(g.M, g.N, F.G, (int)blockIdx.x); pg8::gemm_phase<pg8::EpiX, pg8::StaticOrder>(F.lds + RING_OFF, g, S, E); }
                SEAM();
            }
            if (!is_ffn && RUN(base + 2 * rep + 1)) {
                if (mix == 0) conv_phase(F, BIG, BIG + (size_t)M * 1024, args.in[9] + (size_t)mj * 3 * D);
                else if (mix == 1) attn_naive(F, rep);
                else mlstm_S_naive(F, args.in[14] + mj * 4, args.in[15] + mj * 4);
                SEAM();
            }
        }
        if (!is_ffn && mix == 2 && RUN(base + 2)) { mlstm_O_naive(F, args.in[14] + mj * 4, args.in[15] + mj * 4); SEAM(); }
        if (RUN(base + 6)) {
            pg8::Gemm g; g.M = M; g.N = D; g.bdil = 1; g.K = D; g.lda = D; g.ldb = D;
            if (is_ffn) { g.A = BIG; g.K = FF; g.lda = FF; g.ldb = FF; g.Bt = (const bf16*)(ws + WS_WDN) + (size_t)(layer * 2 + (sub >> 1)) * D * FF; }
            else if (mix == 0) { g.A = BIG; g.Bt = (const bf16*)(ws + WS_WCOUT) + (size_t)mj * D * D; }
            else if (mix == 1) { g.A = R2; g.Bt = (const bf16*)(ws + WS_WAOUT); }
            else { g.A = XN; g.Bt = (const bf16*)(ws + WS_WMOUT); }
            pg8::EpiX E; E.mode = 0; E.O = Y; E.ldc = D; E.O2 = nullptr; E.rope = rope; E.qscale = 1.f;
            pg8::StaticOrder S; S.init(g.M, g.N, F.G, (int)blockIdx.x);
            pg8::gemm_phase<pg8::EpiX, pg8::StaticOrder>(F.lds + RING_OFF, g, S, E);
            SEAM();
        }
        if (RUN(base + 7)) {
            const float* ng = args.in[1] + (size_t)layer * 6 * D;
            const float* gpost = ng + (2 * sub + 1) * D;
            const float* gpre = (sub < 2) ? ng + (2 * sub + 2) * D : (layer < DEPTH - 1 ? ng + 6 * D : nullptr);
            const bool want_gates = (sub == 0 && mix == 2);
            thin_phase(F, args.out, args.out, Y, gpost, is_ffn ? 0.5f : 1.0f, gpre, XN, want_gates ? (const float*)(ws + WS_GATEW) : nullptr, (float*)(ws + WS_GATES));
            SEAM();
        }
    }
#undef RUN
#undef SEAM
}

extern "C" void kernel_launch(void* const* d_in, const int* in_sizes, int n_in, void* d_out, int out_size, void* d_ws, size_t ws_size, hipStream_t stream) {
    static int grid = 0;
    if (grid == 0) {
        if (n_in != 17 || in_sizes[0] != M * D || out_size != M * D || ws_size < WS_END) { fprintf(stderr, "kernel_launch: unexpected shapes (n_in %d, in0 %d, out %d, ws %zu < %zu); nothing launched\n", n_in, n_in > 0 ? in_sizes[0] : -1, out_size, ws_size, (size_t)WS_END); grid = -1; return; }
        int dev = 0, cus = 0, per_cu = 0;
        if (hipGetDevice(&dev) != hipSuccess || hipDeviceGetAttribute(&cus, hipDeviceAttributeMultiprocessorCount, dev) != hipSuccess) { grid = -1; return; }
        if (hipFuncSetAttribute((const void*)mk_fwd, hipFuncAttributeMaxDynamicSharedMemorySize, LDS_BYTES) != hipSuccess) { fprintf(stderr, "kernel_launch: hipFuncSetAttribute failed\n"); grid = -1; return; }
        if (hipOccupancyMaxActiveBlocksPerMultiprocessor(&per_cu, (const void*)mk_fwd, NWAVES * 64, LDS_BYTES) != hipSuccess || per_cu < 1)
            fprintf(stderr, "kernel_launch: note: occupancy query reports %d workgroups per CU\n", per_cu);
        (void)hipGetLastError();
        grid = cus;
    }
    if (grid < 0) return;
    if (hipMemsetAsync((char*)d_ws + WS_CTL, 0, CTL_ZERO_BYTES, stream) != hipSuccess) return;
    Args a{};
    for (int i = 0; i < 17; ++i) a.in[i] = (const float*)d_in[i];
    a.out = (float*)d_out; a.ws = (unsigned char*)d_ws;
#if MK_SPLIT
    for (int id = 0; id < N_PHASE_IDS; ++id) { if (!phase_nonempty(id)) continue; a.ph_lo = id; a.ph_hi = id + 1;
        hipLaunchKernelGGL(mk_fwd, dim3(grid), dim3(NWAVES * 64), LDS_BYTES, stream, a); }
#else
    a.ph_lo = 0; a.ph_hi = N_PHASE_IDS;
    hipLaunchKernelGGL(mk_fwd, dim3(grid), dim3(NWAVES * 64), LDS_BYTES, stream, a);
#endif
    const hipError_t le = hipPeekAtLastError();
    if (le != hipSuccess) fprintf(stderr, "kernel_launch: launch failed: %s\n", hipGetErrorName(le));
}
```

```cpp
#include <hip/hip_runtime.h>
#include <cstdio>
#include <cstdint>
#include <cmath>
namespace pg8 {
#define PG8_LAS __attribute__((address_space(3)))
typedef unsigned short bf16_t;
typedef short bf16x8 __attribute__((ext_vector_type(8)));
typedef float f32x4 __attribute__((ext_vector_type(4)));
typedef unsigned u32x4 __attribute__((ext_vector_type(4)));
constexpr int BM = 256, BK = 64, HALF = 128, HTB = HALF * BK * 2  , STAGE_BYTES = 8 * HTB, NXCD = 8, WGM = 8;

__host__ __device__ __forceinline__ int lds_byte(int r, int c) { const int st = (r >> 4) * 2 + (c >> 5), rr = r & 15, cc = c & 31, ob = rr * 64 + cc * 2; return st * 1024 + (ob ^ (((ob >> 9) & 1) << 5)); }
__host__ __device__ __forceinline__ void stage_rc(int b, int& R, int& C) { const int st = b / 1024, sb = b % 1024, swz = sb ^ (((sb >> 9) & 1) << 5); R = (st >> 1) * 16 + swz / 64; C = (st & 1) * 32 + (swz % 64) / 2; }
__host__ __device__ __forceinline__ int perm32(int rho) { const int n = rho >> 4, i = rho & 15; return 8 * (i >> 2) + 4 * n + (i & 3); }

struct Unit { int pm, pn; };
struct StaticOrder {
    int nM, nN, nwg, G, c;
    __host__ __device__ void init(int M, int N, int G_, int c_) { nM = M / BM; nN = N / BM; nwg = nM * nN; G = G_; c = c_; }
    __host__ __device__ bool next(int i, Unit& u) const {
        const long L = (long)i * G + c; if (L >= nwg) return false;
        int wgid = (int)L; { const int q = nwg / NXCD, r = nwg % NXCD, xcd = wgid % NXCD, off = wgid / NXCD; wgid = (xcd < r ? xcd * (q + 1) : r * (q + 1) + (xcd - r) * q) + off; }
        const int nig = WGM * nN, gid = wgid / nig, fm = gid * WGM, gsz = (nM - fm) < WGM ? (nM - fm) : WGM;
        u.pm = fm + ((wgid % nig) % gsz); u.pn = (wgid % nig) / gsz; return true;
    }
    __device__ __forceinline__ void a_ready(const Unit&) const {}
    __device__ __forceinline__ void done(const Unit&) const {}
};
__device__ __forceinline__ unsigned cvt_pk_bf16(float lo, float hi) { unsigned r; asm volatile("v_cvt_pk_bf16_f32 %0, %1, %2" : "=v"(r) : "v"(lo), "v"(hi)); return r; }
typedef float f32x2 __attribute__((ext_vector_type(2)));

struct Gemm { const bf16_t* A; const bf16_t* Bt; int M, N, K, lda, ldb, bdil; };

__device__ __forceinline__ unsigned b_half_off(const Gemm& g, int pn, int h) {
    const int p0 = pn * BM + h * HALF; int row = p0;
    if (g.bdil != 1) { const int L = 2048 / g.bdil, b = p0 >> 11, pp = p0 & 2047, r = pp / L, u0 = pp - r * L; row = (b << 11) + u0 * g.bdil + r; }
    return (unsigned)row * (unsigned)g.ldb * 2u;
}

__device__ __forceinline__ f32x4 silu4(f32x4 v) {
    f32x4 o;
#pragma unroll
    for (int i = 0; i < 4; ++i) { const float e = __builtin_amdgcn_exp2f(v[i] * -1.4426950408889634f); o[i] = v[i] * __builtin_amdgcn_rcpf(1.0f + e); }
    return o;
}

struct EpiX {
    static constexpr bool PERM = true;
    int mode; bf16_t* O; int ldc; bf16_t* O2; const float* rope; float qscale;
    const float* rs; int rsm, cdil, gsh;
    __device__ __forceinline__ static void store8(bf16_t* p, const f32x4 v0, const f32x4 v1) {
        u32x4 w; w.x = cvt_pk_bf16(v0[0], v0[1]); w.y = cvt_pk_bf16(v0[2], v0[3]); w.z = cvt_pk_bf16(v1[0], v1[1]); w.w = cvt_pk_bf16(v1[2], v1[3]); *(u32x4*)p = w; }
    __device__ __forceinline__ void operator()(const f32x4 (&acc)[2][2][4][2], const Unit& u, int wr, int wc, int fr, int fq, const PG8_LAS float* rsl) const {
        const int row0 = u.pm * BM + wr * 64 + fr;
        const bool pair = (mode == 1) || (mode == 2 && u.pn >= 4);
        if (pair) {
            bf16_t* base = (mode == 1) ? O : O2; const int pnn = (mode == 1) ? u.pn : u.pn - 4; const int ld = (mode == 1) ? ldc : 1024;
            const int col0 = pnn * HALF + wc * 32 + 8 * fq;
#pragma unroll
            for (int ai = 0; ai < 2; ++ai)
#pragma unroll
                for (int m = 0; m < 4; ++m) { const int row = row0 + ai * HALF + m * 16; bf16_t* rowp = base + (size_t)row * ld + col0; const float rsc = rsl[row - u.pm * BM], r2 = rsc * rsc;
                    const f32x4 a0 = acc[ai][0][m][0], a1 = acc[ai][0][m][1], b0 = acc[ai][1][m][0], b1 = acc[ai][1][m][1];
                    f32x4 o0 = (a0 * b0) * r2, o1 = (a1 * b1) * r2;
                    if (mode == 1) { const float k2 = -1.4426950408889634f * rsc; const f32x4 t0 = a0 * k2, t1 = a1 * k2; f32x4 e0, e1;
#pragma unroll
                        for (int i = 0; i < 4; ++i) { e0[i] = __builtin_amdgcn_exp2f(t0[i]); e1[i] = __builtin_amdgcn_exp2f(t1[i]); }
                        e0 = e0 + 1.0f; e1 = e1 + 1.0f;
#pragma unroll
                        for (int i = 0; i < 4; ++i) { e0[i] = __builtin_amdgcn_rcpf(e0[i]); e1[i] = __builtin_amdgcn_rcpf(e1[i]); }
                        o0 = o0 * e0; o1 = o1 * e1; }
                    store8(rowp, o0, o1); }
        } else {
            const int col0 = u.pn * BM + wc * 32 + 8 * fq;
            float sc = 1.f; bool dorope = false;
            if (mode == 3) { if (u.pn < 4) sc = qscale; dorope = ((wc & 1) == 0); }
            if (mode == 4) { if (u.pn < 2) sc = qscale; }
            f32x4 cs[2][2];
#pragma unroll
            for (int bj = 0; bj < 2; ++bj) { cs[bj][0] = (f32x4){1.f, 1.f, 1.f, 1.f}; cs[bj][1] = cs[bj][0]; }
            if (rsm == 2) {
#pragma unroll
                for (int bj = 0; bj < 2; ++bj) { const int p0 = col0 + bj * HALF; int t0 = p0, st = 1;
                    if (cdil != 1) { const int L = 2048 / cdil, bb = p0 >> 11, pp = p0 & 2047, r = pp / L, u0 = pp - r * L; t0 = (bb << 11) + u0 * cdil + r; st = cdil; }
#pragma unroll
                    for (int e = 0; e < 4; ++e) { cs[bj][0][e] = rs[t0 + e * st]; cs[bj][1][e] = rs[t0 + (4 + e) * st]; } }
            }
#pragma unroll
            for (int ai = 0; ai < 2; ++ai)
#pragma unroll
                for (int m = 0; m < 4; ++m) { const int row = row0 + ai * HALF + m * 16; bf16_t* rowp = O + (size_t)row * ldc + col0; const float rsc = (rsm == 1) ? rsl[row - u.pm * BM] * sc : sc;
                    f32x4 c0 = (f32x4){1.f, 1.f, 1.f, 1.f}, c1 = c0, s0 = (f32x4){0.f, 0.f, 0.f, 0.f}, s1 = s0;
                    if (dorope) { const float* tp = rope + (size_t)(row & 2047) * 16; c0 = *(const f32x4*)(tp); c1 = *(const f32x4*)(tp + 4); s0 = *(const f32x4*)(tp + 8); s1 = *(const f32x4*)(tp + 12);
                        if (fq == 0) { s0 = -s0; s1 = -s1; } }
#pragma unroll
                    for (int bj = 0; bj < 2; ++bj) { f32x4 v0 = acc[ai][bj][m][0], v1 = acc[ai][bj][m][1];
                        if (dorope) { f32x4 p0, p1;
#pragma unroll
                            for (int e = 0; e < 4; ++e) { p0[e] = __shfl_xor(v0[e], 16); p1[e] = __shfl_xor(v1[e], 16); }
                            if (fq < 2) { v0 = v0 * c0 + p0 * s0; v1 = v1 * c1 + p1 * s1; } }
                        v0 = v0 * rsc * cs[bj][0]; v1 = v1 * rsc * cs[bj][1];
                        if (mode == 3 || (mode == 4 && u.pn < 4)) {
                            const int c0 = col0 + bj * HALF; size_t off;
                            if (mode == 3) { const int bb = row >> 11, tt = row & 2047, r = tt & ((1 << gsh) - 1), uu = tt >> gsh, tile = bb * 64 + (r << (6 - gsh)) + (uu >> 5);
                                const int sec = c0 >> 10, hc = c0 & 1023, hh = hc >> 6, dc = (hc >> 3) & 7;
                                off = (size_t)sec * ((size_t)16384 * 1024) + ((size_t)((tile * 16 + hh) * 4 + (dc >> 1)) * 512) + ((uu & 31) + 32 * (dc & 1)) * 8; }
                            else { const int tile = row >> 5, sec = c0 >> 9, hc = c0 & 511, hh = hc >> 7, dc = (hc >> 3) & 15;
                                off = (size_t)sec * ((size_t)16384 * 512) + ((size_t)((tile * 4 + hh) * 8 + (dc >> 1)) * 512) + ((row & 31) + 32 * (dc & 1)) * 8; }
                            store8(O + off, v0, v1);
                        } else if (mode == 4) { store8(O2 + (size_t)row * 1024 + (col0 + bj * HALF - 1024), v0, v1);
                        } else if (rsm == 2) {
                            const int p0 = col0 + bj * HALF; store8(O + ((size_t)(row >> 5) * (size_t)(ldc >> 4) + (p0 >> 4)) * 512 + ((row & 31) + 32 * ((p0 >> 3) & 1)) * 8, v0, v1);
                        } else store8(rowp + bj * HALF, v0, v1); } }
        }
    }
};

template <class Epi, class Sched>
__device__ __forceinline__ void gemm_phase(PG8_LAS unsigned char* lds, const Gemm g, const Sched& S, const Epi& E) {
    int tid = threadIdx.x; asm volatile("" : "+v"(tid));
    const int wid = __builtin_amdgcn_readfirstlane(tid >> 6), lane = tid & 63, wr = wid >> 2, wc = wid & 3, fr = lane & 15, fq = lane >> 4;
    const int K = g.K, nt = K / BK;
    unsigned voffA[2], voffB[2];
#pragma unroll
    for (int i = 0; i < 2; ++i) { int R, C; stage_rc(tid * 16 + i * 8192, R, C); const int Rb = Epi::PERM ? ((R & ~31) + perm32(R & 31)) : R;
        voffA[i] = (unsigned)(R * g.lda + C) * 2u; voffB[i] = (unsigned)(Rb * g.bdil * g.ldb + C) * 2u; }
    const unsigned kstep = (unsigned)(BK * 2);
    const unsigned hstepA = (unsigned)HALF * (unsigned)g.lda * 2u;
    const unsigned tstepA = 2u * hstepA;
    const char* const baseA = (const char*)g.A; const char* const baseB = (const char*)g.Bt;
    const unsigned ldsw = (unsigned)wid * 1024u;
    const int aoff = lds_byte(wr * 64 + fr, fq * 8), boff = lds_byte(wc * 32 + fr, fq * 8);
#define PG8_SA(b, h) (((b) * 2 + (h)) * HTB)
#define PG8_SB(b, h) ((4 + (b) * 2 + (h)) * HTB)
#define PG8_STAGE(bufoff, gbase, uoff, voff) do { _Pragma("unroll") for (int _i = 0; _i < 2; ++_i) \
        __builtin_amdgcn_global_load_lds((const unsigned*)((gbase) + (size_t)((unsigned)(uoff) + (voff)[_i])), (PG8_LAS unsigned*)(lds + (bufoff) + ldsw + _i * 8192), 16, 0, 0); } while (0)
#define PG8_LDA(dst, b, h) do { _Pragma("unroll") for (int m = 0; m < 4; ++m) _Pragma("unroll") for (int k = 0; k < 2; ++k) dst[m][k] = *(const PG8_LAS bf16x8*)(lds + PG8_SA(b, h) + aoff + m * 2048 + k * 1024); } while (0)
#define PG8_LDB(dst, b, h) do { _Pragma("unroll") for (int n = 0; n < 2; ++n) _Pragma("unroll") for (int k = 0; k < 2; ++k) dst[n][k] = *(const PG8_LAS bf16x8*)(lds + PG8_SB(b, h) + boff + n * 2048 + k * 1024); } while (0)
#define PG8_MMA(ai, bj, At, Bt) do { __builtin_amdgcn_s_setprio(1); _Pragma("unroll") for (int m = 0; m < 4; ++m) _Pragma("unroll") for (int n = 0; n < 2; ++n) _Pragma("unroll") for (int k = 0; k < 2; ++k) \
        acc[ai][bj][m][n] = __builtin_amdgcn_mfma_f32_16x16x32_bf16(Bt[n][k], At[m][k], acc[ai][bj][m][n], 0, 0, 0); __builtin_amdgcn_s_setprio(0); } while (0)
#ifndef PROBE_XMFMA
#define PROBE_XMFMA 0
#endif
#define PG8_XMMA() do { const bf16x8 z_ = (bf16x8){0, 0, 0, 0, 0, 0, 0, 0}; _Pragma("unroll") for (int x_ = 0; x_ < PROBE_XMFMA; ++x_) acc[1][1][x_ & 3][(x_ >> 2) & 1] = __builtin_amdgcn_mfma_f32_16x16x32_bf16(z_, At[x_ & 3][0], acc[1][1][x_ & 3][(x_ >> 2) & 1], 0, 0, 0); } while (0)
#ifndef PG8_ALIGN_EPI
#define PG8_ALIGN_EPI 1
#endif
#define PG8_WAIT_V(n) asm volatile("s_waitcnt vmcnt(" #n ")" ::: "memory")
#define PG8_WAIT_L(n) asm volatile("s_waitcnt lgkmcnt(" #n ")" ::: "memory")
#define PG8_BAR __builtin_amdgcn_s_barrier()
#define PG8_SCHED __builtin_amdgcn_sched_barrier(0)
    Unit cur, nxt; int ui = 0;
    if (!S.next(0, cur)) return;
    f32x4 acc[2][2][4][2];
#pragma unroll
    for (int a = 0; a < 2; ++a)
#pragma unroll
        for (int b = 0; b < 2; ++b)
#pragma unroll
            for (int m = 0; m < 4; ++m)
#pragma unroll
                for (int n = 0; n < 2; ++n) acc[a][b][m][n] = (f32x4){0.f, 0.f, 0.f, 0.f};
    bf16x8 At[4][2], B0[2][2], B1[2][2];
    unsigned cA = (unsigned)cur.pm * tstepA, cB0 = b_half_off(g, cur.pn, 0), cB1 = b_half_off(g, cur.pn, 1);
#define PG8_RSL(par) ((PG8_LAS float*)(lds + STAGE_BYTES + 2048 + (par) * 1024))
#define PG8_STAGE_RS(un, par) do { if (E.rsm == 1 && wid < 4) __builtin_amdgcn_global_load_lds((const unsigned*)(E.rs + (size_t)(un).pm * BM + wid * 64 + lane), (PG8_LAS unsigned*)(PG8_RSL(par) + wid * 64), 4, 0, 0); } while (0)
    PG8_STAGE_RS(cur, 0);
    PG8_STAGE(PG8_SB(0, 0), baseB, cB0, voffB); PG8_STAGE(PG8_SB(0, 1), baseB, cB1, voffB); PG8_STAGE(PG8_SA(0, 0), baseA, cA, voffA); PG8_STAGE(PG8_SA(0, 1), baseA, cA + hstepA, voffA);
    if (wr == 1) PG8_BAR;
    PG8_WAIT_V(2); PG8_BAR;
    PG8_STAGE(PG8_SB(1, 0), baseB, cB0 + kstep, voffB); PG8_STAGE(PG8_SA(1, 0), baseA, cA + kstep, voffA); PG8_STAGE(PG8_SB(1, 1), baseB, cB1 + kstep, voffB);
    PG8_WAIT_V(6); PG8_BAR;
    for (;;) {
        const bool has_next = S.next(ui + 1, nxt);
        const unsigned nA = has_next ? (unsigned)nxt.pm * tstepA : cA;
        const unsigned nB0 = has_next ? b_half_off(g, nxt.pn, 0) : cB0, nB1 = has_next ? b_half_off(g, nxt.pn, 1) : cB1;
        for (int t = 0; t < nt; t += 2) {
            const bool last = (t == nt - 2);
            const unsigned a1 = cA + (unsigned)(t + 1) * kstep;
            const unsigned a2 = last ? nA : cA + (unsigned)(t + 2) * kstep;
            const unsigned b2_0 = last ? nB0 : cB0 + (unsigned)(t + 2) * kstep, b2_1 = last ? nB1 : cB1 + (unsigned)(t + 2) * kstep;
            const unsigned a3 = a2 + kstep, b3_0 = b2_0 + kstep, b3_1 = b2_1 + kstep;
            PG8_LDB(B0, 0, 0); PG8_LDB(B1, 0, 1); PG8_SCHED; PG8_LDA(At, 0, 0); PG8_STAGE(PG8_SA(1, 1), baseA, a1 + hstepA, voffA);
            PG8_WAIT_V(8); PG8_WAIT_L(0); PG8_BAR; PG8_MMA(0, 0, At, B0); PG8_MMA(0, 1, At, B1); PG8_BAR; PG8_SCHED;
            PG8_LDA(At, 0, 1); PG8_STAGE(PG8_SB(0, 0), baseB, b2_0, voffB); PG8_STAGE(PG8_SB(0, 1), baseB, b2_1, voffB); PG8_STAGE(PG8_SA(0, 0), baseA, a2, voffA);
            PG8_WAIT_V(8); PG8_WAIT_L(0); PG8_BAR; PG8_MMA(1, 0, At, B0); PG8_MMA(1, 1, At, B1); PG8_XMMA(); PG8_BAR; PG8_SCHED;
            PG8_LDB(B0, 1, 0); PG8_LDB(B1, 1, 1); PG8_SCHED; PG8_LDA(At, 1, 0); PG8_STAGE(PG8_SA(0, 1), baseA, a2 + hstepA, voffA);
            PG8_WAIT_V(8); PG8_WAIT_L(0); PG8_BAR; PG8_MMA(0, 0, At, B0); PG8_MMA(0, 1, At, B1); PG8_BAR; PG8_SCHED;
            PG8_LDA(At, 1, 1); PG8_STAGE(PG8_SB(1, 0), baseB, b3_0, voffB); PG8_STAGE(PG8_SB(1, 1), baseB, b3_1, voffB); PG8_STAGE(PG8_SA(1, 0), baseA, a3, voffA);
            PG8_WAIT_V(8); PG8_WAIT_L(0); PG8_BAR; PG8_MMA(1, 0, At, B0); PG8_MMA(1, 1, At, B1); PG8_XMMA(); PG8_BAR; PG8_SCHED;
        }
        if (PG8_ALIGN_EPI) { if (wr == 0) PG8_BAR; }
        E(acc, cur, wr, wc, fr, fq, PG8_RSL(ui & 1));
        if (!has_next) break;
#pragma unroll
        for (int a = 0; a < 2; ++a)
#pragma unroll
            for (int b = 0; b < 2; ++b)
#pragma unroll
                for (int m = 0; m < 4; ++m)
#pragma unroll
                    for (int n = 0; n < 2; ++n) acc[a][b][m][n] = (f32x4){0.f, 0.f, 0.f, 0.f};
        cur = nxt; cA = nA; cB0 = nB0; cB1 = nB1; ++ui;
        PG8_STAGE_RS(cur, ui & 1);
        if (PG8_ALIGN_EPI) { if (wr == 1) PG8_BAR; }
    }
    PG8_WAIT_V(0);
    if (!PG8_ALIGN_EPI) { if (wr == 0) PG8_BAR; }
    PG8_BAR;
#undef PG8_RSL
#undef PG8_STAGE_RS
#undef PG8_SA
#undef PG8_SB
#undef PG8_STAGE
#undef PG8_LDA
#undef PG8_LDB
#undef PG8_MMA
#undef PG8_XMMA
#undef PG8_WAIT_V
#undef PG8_WAIT_L
#undef PG8_BAR
#undef PG8_SCHED
}
}
#define GAS __attribute__((address_space(1)))
#define LAS __attribute__((address_space(3)))
typedef unsigned short bf16;
typedef unsigned v4u __attribute__((ext_vector_type(4)));
typedef float f32x4 __attribute__((ext_vector_type(4)));
typedef short bf16x8 __attribute__((ext_vector_type(8)));
typedef GAS unsigned gu32;
typedef GAS unsigned long long gu64;
#define RLX_AGENT __ATOMIC_RELAXED, __HIP_MEMORY_SCOPE_AGENT
#define LDS_WAIT() asm volatile("s_waitcnt lgkmcnt(0)" ::: "memory")
#define VM_WAIT() asm volatile("s_waitcnt vmcnt(0)" ::: "memory")
__device__ __forceinline__ unsigned long long rt() { return __builtin_amdgcn_s_memrealtime(); }
__device__ __forceinline__ unsigned f2bf(float f) { unsigned u = __builtin_bit_cast(unsigned, f); return (u + 0x7fffu + ((u >> 16) & 1u)) >> 16; }
__device__ __forceinline__ unsigned pk2(float lo, float hi) { return f2bf(lo) | (f2bf(hi) << 16); }

#define XB_TMO      128
#define XB_XCNT(j)  (256  + 64 * (j))
#define XB_XSUB(j)  (1280 + 64 * (j))
#define XB_XGEN(j)  (2304 + 64 * (j))
#define XB_TOP      3328
#define XB_TOPGEN   3392
#define XCD_BAR_WORDS 3456
#define XB_SPIN_CAP (1u << 18)

__device__ __forceinline__ unsigned xb_ld(unsigned* p)              { return __hip_atomic_load(p, __ATOMIC_RELAXED, __HIP_MEMORY_SCOPE_AGENT); }
__device__ __forceinline__ unsigned xb_add(unsigned* p, unsigned v) { return __hip_atomic_fetch_add(p, v, __ATOMIC_RELAXED, __HIP_MEMORY_SCOPE_AGENT); }
__device__ __forceinline__ unsigned xb_xcc_id() { return (unsigned)__builtin_amdgcn_s_getreg((3 << 11) | 20) & 0xFu; }
#define XB_SPIN(cond, bar) do { unsigned _sp = 0; while (cond) { __builtin_amdgcn_s_sleep(1); \
    if ((++_sp & 255u) == 0u) { if (xb_ld(&(bar)[XB_TMO])) break; if (_sp > XB_SPIN_CAP) { atomicAdd(&(bar)[XB_TMO], 1u); break; } } } } while (0)

struct XcdBarrier {
    unsigned* bar; unsigned x;
    volatile LAS unsigned* st;
};

__device__ __forceinline__ XcdBarrier xcd_barrier_post(unsigned* bar, volatile LAS unsigned* st) {
    XcdBarrier b; b.bar = bar; b.x = xb_xcc_id(); b.st = st;
    if (threadIdx.x == 0) (void)xb_add(&bar[XB_XCNT(b.x)], 1u);
    return b;
}
__device__ __forceinline__ void xcd_barrier_complete(unsigned* bar, unsigned x, unsigned& nloc, unsigned& nx) {
    const unsigned G = gridDim.x * gridDim.y * gridDim.z;
    unsigned sum, cnt, mine, sp = 0u;
    for (;;) {
        sum = 0u; cnt = 0u; mine = 0u;
#pragma unroll
        for (unsigned j = 0; j < 16; ++j) { const unsigned c = xb_ld(&bar[XB_XCNT(j)]); sum += c; cnt += (c > 0u) ? 1u : 0u; mine = (j == x) ? c : mine; }
        if (sum == G) break;
        __builtin_amdgcn_s_sleep(1);
        if ((++sp & 255u) == 0u) { if (xb_ld(&bar[XB_TMO])) break; if (sp > XB_SPIN_CAP) { atomicAdd(&bar[XB_TMO], 1u); break; } }
    }
    nloc = mine > 0u ? mine : 1u; nx = cnt > 0u ? cnt : 1u;
}

__device__ __forceinline__ void xcd_barrier(const XcdBarrier& b) {
    asm volatile("s_waitcnt vmcnt(0)" ::: "memory");
    __syncthreads();
    if (threadIdx.x == 0) {
        unsigned* bar = b.bar;
        __builtin_amdgcn_s_waitcnt(0);
        unsigned nloc = b.st[0], nx = b.st[1];
        if (nloc == 0u) { xcd_barrier_complete(bar, b.x, nloc, nx); b.st[0] = nloc; b.st[1] = nx; }
        const unsigned old = xb_add(&bar[XB_XSUB(b.x)], 1u);
        const unsigned gen = old / nloc;
        if (old + 1u == (gen + 1u) * nloc) {
            __builtin_amdgcn_fence(__ATOMIC_RELEASE, "agent");
            asm volatile("s_waitcnt vmcnt(0)" ::: "memory");
            const unsigned og = xb_add(&bar[XB_TOP], 1u);
            const unsigned tg = og / nx;
            if (og + 1u == (tg + 1u) * nx) xb_add(&bar[XB_TOPGEN], 1u);
            else XB_SPIN(xb_ld(&bar[XB_TOPGEN]) == tg, bar);
            __builtin_amdgcn_fence(__ATOMIC_ACQUIRE, "agent");
            xb_add(&bar[XB_XGEN(b.x)], 1u);
            asm volatile("s_waitcnt vmcnt(0)" ::: "memory");
        } else {
            XB_SPIN(xb_ld(&bar[XB_XGEN(b.x)]) == gen, bar);
            __builtin_amdgcn_fence(__ATOMIC_ACQUIRE, "agent");
            asm volatile("s_waitcnt vmcnt(0)" ::: "memory");
        }
    }
    __syncthreads();
}

constexpr int NWAVES = 8;
constexpr int BATCH = 8, SEQ = 2048, D = 1024, FF = 2816, DEPTH = 4;
constexpr int M = BATCH * SEQ;
constexpr float EPS = 1e-6f;
constexpr int ML_PROJ = 3080;
constexpr float ATT_QSCALE = 0.125f * 1.4426950408889634f;
constexpr int LDX = D + 64;
constexpr int LDQ = 2048 + 64;
constexpr int LDT = M + 64;
constexpr float ML_QSCALE = 0.08838834764831845f;

constexpr size_t MiB = 1u << 20;
constexpr size_t WS_CTL = 0, CTL_ZERO_BYTES = 32768;
constexpr size_t WS_ROPE = 1 * MiB;
constexpr size_t WS_GATEW = WS_ROPE + 256 * 1024;
constexpr size_t WS_GATES = WS_ROPE + 512 * 1024;
constexpr size_t WS_LSE = 2 * MiB;
constexpr size_t WS_NST = 3 * MiB;
constexpr size_t WS_MST = 3 * MiB + 512 * 1024;
constexpr size_t WS_RS = 5 * MiB;
constexpr size_t WS_GV = 4 * MiB;
constexpr size_t WS_WUP = 8 * MiB;
constexpr size_t WS_WDN = 96 * MiB;
constexpr size_t WS_WCIN = 140 * MiB;
constexpr size_t WS_WCOUT = 152 * MiB;
constexpr size_t WS_WAIN = 156 * MiB;
constexpr size_t WS_WAOUT = 174 * MiB;
constexpr size_t WS_WMIN = 176 * MiB;
constexpr size_t WS_WMOUT = 183 * MiB;
constexpr size_t WS_XN = 186 * MiB;
constexpr size_t WS_BIG = 220 * MiB;
constexpr size_t WS_TR = WS_BIG + 66 * MiB;
constexpr size_t WS_Y = WS_BIG + 88 * MiB;
constexpr size_t WS_R2 = 340 * MiB;
constexpr size_t WS_END = 406 * MiB;
static_assert((size_t)M * LDX * 2 <= 34 * MiB && (size_t)M * LDQ * 2 <= 66 * MiB && (size_t)1536 * LDT * 2 <= 54 * MiB, "d_ws map");
constexpr int CW_BAR = 4096;

constexpr int RING_OFF = 0, RING_BYTES = 131072;
constexpr int LDS_BYTES = 147456;
constexpr int MISC_OFF = LDS_BYTES - 512;

struct Args { const float* in[17]; float* out; unsigned char* ws; int ph_lo, ph_hi; };

struct Frame {
    LAS unsigned char* lds;
    volatile LAS unsigned* MISC;
    gu32* ctl;
    int vcu, G;
    unsigned char* ws;
};
struct LaneId { int tid, lane, wave; };
__device__ __forceinline__ LaneId lane_id() { int t = threadIdx.x; asm volatile("" : "+v"(t)); LaneId L; L.tid = t; L.lane = t & 63; L.wave = __builtin_amdgcn_readfirstlane(t >> 6); return L; }

__device__ __forceinline__ float wave_sum(float v) {
#pragma unroll
    for (int o = 1; o < 64; o <<= 1) v += __shfl_xor(v, o);
    return v;
}
__device__ __forceinline__ float wave_max(float v) {
#pragma unroll
    for (int o = 1; o < 64; o <<= 1) v = fmaxf(v, __shfl_xor(v, o));
    return v;
}
__device__ __forceinline__ float wave_incl_sum(float v, int lane) {
#pragma unroll
    for (int o = 1; o < 64; o <<= 1) { const float t = __shfl_up(v, o); if (lane >= o) v += t; }
    return v;
}
__device__ __forceinline__ float wave_incl_max(float v, int lane) {
#pragma unroll
    for (int o = 1; o < 64; o <<= 1) { const float t = __shfl_up(v, o); if (lane >= o) v = fmaxf(v, t); }
    return v;
}
__device__ __forceinline__ float bflo(unsigned w) { return __uint_as_float(w << 16); }
__device__ __forceinline__ float bfhi(unsigned w) { return __uint_as_float(w & 0xffff0000u); }
__device__ __forceinline__ float bf2f(bf16 u) { return __uint_as_float((unsigned)u << 16); }
__device__ __forceinline__ float dot8(const v4u a, const v4u b, float acc) {
    acc += bflo(a.x) * bflo(b.x); acc += bfhi(a.x) * bfhi(b.x); acc += bflo(a.y) * bflo(b.y); acc += bfhi(a.y) * bfhi(b.y);
    acc += bflo(a.z) * bflo(b.z); acc += bfhi(a.z) * bfhi(b.z); acc += bflo(a.w) * bflo(b.w); acc += bfhi(a.w) * bfhi(b.w); return acc;
}
__device__ __forceinline__ float bfel(const v4u a, int i) { const unsigned w = a[i >> 1]; return (i & 1) ? bfhi(w) : bflo(w); }
__device__ __forceinline__ float ld_f32_coherent(const float* p) { return __uint_as_float(__hip_atomic_load((const unsigned*)p, RLX_AGENT)); }
__device__ __forceinline__ float logsigmoid_f(float x) { return fminf(x, 0.f) - log1pf(expf(-fabsf(x))); }

__device__ __forceinline__ void thin_phase(Frame& F, const float* xin, bf16* X, const bf16* y, const float* gpost, float pscale, float* rs, float* fout, const float* gatew, float* gates) {
    const LaneId li = lane_id(); const int lane = li.lane; int gw = F.vcu * NWAVES + li.wave, NGW = F.G * NWAVES, mEnd = M;
    if (F.G == 256) { const int c_ = (int)blockIdx.x; gw = 256 * (8 * (c_ & 7) + ((c_ >> 3) & 7)) + 64 * (c_ >> 6) + 8 * li.wave; NGW = 1; mEnd = gw + 8; }
    f32x4 gp[4];
#pragma unroll
    for (int i = 0; i < 4; ++i) { const int col = 512 * (i >> 1) + 8 * lane + 4 * (i & 1); gp[i] = gpost ? *(const f32x4*)(gpost + col) : (f32x4){0.f, 0.f, 0.f, 0.f}; }
    for (int m0 = gw; m0 < mEnd; m0 += 2 * NGW) {
        f32x4 xv[2][4]; f32x4 yf[2][4];
#pragma unroll
        for (int rr = 0; rr < 2; ++rr) { const int m = (m0 + rr * NGW < mEnd) ? m0 + rr * NGW : m0;
            if (xin) {
#pragma unroll
                for (int i = 0; i < 4; ++i) xv[rr][i] = *(const GAS f32x4*)(xin + (size_t)m * D + 512 * (i >> 1) + 8 * lane + 4 * (i & 1));
            } else {
#pragma unroll
                for (int j = 0; j < 2; ++j) { const v4u w = *(const GAS v4u*)(X + (size_t)m * LDX + 512 * j + 8 * lane);
                    xv[rr][2 * j] = (f32x4){bflo(w.x), bfhi(w.x), bflo(w.y), bfhi(w.y)}; xv[rr][2 * j + 1] = (f32x4){bflo(w.z), bfhi(w.z), bflo(w.w), bfhi(w.w)}; }
            }
            if (y) {
#pragma unroll
                for (int j = 0; j < 2; ++j) { const v4u w = *(const GAS v4u*)(y + (size_t)m * D + 512 * j + 8 * lane);
                    yf[rr][2 * j] = (f32x4){bflo(w.x), bfhi(w.x), bflo(w.y), bfhi(w.y)}; yf[rr][2 * j + 1] = (f32x4){bflo(w.z), bfhi(w.z), bflo(w.w), bfhi(w.w)}; }
            }
        }
        if (y) {
            float ssq[2];
#pragma unroll
            for (int rr = 0; rr < 2; ++rr) { ssq[rr] = 0.f;
#pragma unroll
                for (int i = 0; i < 4; ++i) ssq[rr] += (yf[rr][i].x * yf[rr][i].x + yf[rr][i].y * yf[rr][i].y) + (yf[rr][i].z * yf[rr][i].z + yf[rr][i].w * yf[rr][i].w); }
#pragma unroll
            for (int o = 1; o < 64; o <<= 1) { ssq[0] += __shfl_xor(ssq[0], o); ssq[1] += __shfl_xor(ssq[1], o); }
#pragma unroll
            for (int rr = 0; rr < 2; ++rr) { const float r1 = pscale / sqrtf(ssq[rr] * (1.f / D) + EPS);
#pragma unroll
                for (int i = 0; i < 4; ++i) xv[rr][i] = xv[rr][i] + yf[rr][i] * gp[i] * r1; }
        }
        if (fout) {
#pragma unroll
            for (int rr = 0; rr < 2; ++rr) { const int m = m0 + rr * NGW; if (m < mEnd) {
#pragma unroll
                for (int i = 0; i < 4; ++i) *(GAS f32x4*)(fout + (size_t)m * D + 512 * (i >> 1) + 8 * lane + 4 * (i & 1)) = xv[rr][i]; } }
        } else {
            float ssq[2];
#pragma unroll
            for (int rr = 0; rr < 2; ++rr) { ssq[rr] = 0.f;
#pragma unroll
                for (int i = 0; i < 4; ++i) ssq[rr] += (xv[rr][i].x * xv[rr][i].x + xv[rr][i].y * xv[rr][i].y) + (xv[rr][i].z * xv[rr][i].z + xv[rr][i].w * xv[rr][i].w); }
#pragma unroll
            for (int o = 1; o < 64; o <<= 1) { ssq[0] += __shfl_xor(ssq[0], o); ssq[1] += __shfl_xor(ssq[1], o); }
#pragma unroll
            for (int rr = 0; rr < 2; ++rr) { const int m = m0 + rr * NGW; if (m < mEnd) {
                const float r2 = 1.f / sqrtf(ssq[rr] * (1.f / D) + EPS);
#pragma unroll
                for (int j = 0; j < 2; ++j) { v4u w; w.x = pk2(xv[rr][2 * j].x, xv[rr][2 * j].y); w.y = pk2(xv[rr][2 * j].z, xv[rr][2 * j].w); w.z = pk2(xv[rr][2 * j + 1].x, xv[rr][2 * j + 1].y); w.w = pk2(xv[rr][2 * j + 1].z, xv[rr][2 * j + 1].w);
                    *(GAS v4u*)(X + (size_t)m * LDX + 512 * j + 8 * lane) = w; }
                if (lane == 0) rs[m] = r2;
                if (gatew) {
                    float mine = 0.f;
#pragma unroll
                    for (int jg = 0; jg < 8; ++jg) { float s = 0.f;
#pragma unroll
                        for (int i = 0; i < 4; ++i) { const f32x4 wv = *(const GAS f32x4*)(gatew + jg * D + 512 * (i >> 1) + 8 * lane + 4 * (i & 1)); s += (xv[rr][i].x * wv.x + xv[rr][i].y * wv.y) + (xv[rr][i].z * wv.z + xv[rr][i].w * wv.w); }
                        s = wave_sum(s); if (lane == jg) mine = s * r2; }
                    if (lane < 8) gates[(size_t)m * 8 + lane] = mine;
                }
            } }
        }
    }
}

__device__ __forceinline__ void conv_phase(Frame& F, bf16* Bz, const bf16* CU, const float* ck) {
    const LaneId li = lane_id(); const int gw = F.vcu * NWAVES + li.wave, NGW = F.G * NWAVES, lane = li.lane;
    f32x4 kk[3][4];
#pragma unroll
    for (int l = 0; l < 3; ++l)
#pragma unroll
        for (int i = 0; i < 4; ++i) kk[l][i] = *(const f32x4*)(ck + l * D + 512 * (i >> 1) + 8 * lane + 4 * (i & 1));
    const int per = (M + NGW - 1) / NGW;
    const int m_lo = gw * per, m_hi = (m_lo + per < M) ? m_lo + per : M;
    v4u c1[2], c2[2];
#pragma unroll
    for (int j = 0; j < 2; ++j) { c1[j] = (v4u){0u, 0u, 0u, 0u}; c2[j] = c1[j]; }
    if (m_lo < M) { const int t0 = m_lo & (SEQ - 1);
#pragma unroll
        for (int j = 0; j < 2; ++j) { const size_t off = (size_t)m_lo * D + 512 * j + 8 * lane;
            if (t0 >= 1) c1[j] = *(const GAS v4u*)(CU + off - D);
            if (t0 >= 2) c2[j] = *(const GAS v4u*)(CU + off - 2 * D); } }
    for (int m = m_lo; m < m_hi; ++m) {
        if ((m & (SEQ - 1)) == 0) {
#pragma unroll
            for (int j = 0; j < 2; ++j) { c1[j] = (v4u){0u, 0u, 0u, 0u}; c2[j] = c1[j]; } }
#pragma unroll
        for (int j = 0; j < 2; ++j) {
            const size_t off = (size_t)m * D + 512 * j + 8 * lane;
            const v4u bw = *(const GAS v4u*)(Bz + off); const v4u c0 = *(const GAS v4u*)(CU + off);
            float z[8];
#pragma unroll
            for (int e = 0; e < 8; ++e) { const f32x4 k0 = kk[0][2 * j + (e >> 2)], k1 = kk[1][2 * j + (e >> 2)], k2 = kk[2][2 * j + (e >> 2)];
                z[e] = bfel(bw, e) * (k0[e & 3] * bfel(c0, e) + k1[e & 3] * bfel(c1[j], e) + k2[e & 3] * bfel(c2[j], e)); }
            v4u w; w.x = pk2(z[0], z[1]); w.y = pk2(z[2], z[3]); w.z = pk2(z[4], z[5]); w.w = pk2(z[6], z[7]);
            *(GAS v4u*)(Bz + off) = w;
            c2[j] = c1[j]; c1[j] = c0;
        }
    }
}

__device__ __forceinline__ void transpose_tile(const float* src, int ld, int k0, int n0, bf16* dst, int Kd, LAS float* scr, int lane, const float* gk) {
    f32x4 v[16]; float gv[16];
#pragma unroll
    for (int i = 0; i < 16; ++i) { const int kk = 4 * i + (lane >> 4), c4 = (lane & 15) * 4;
        v[i] = *(const f32x4*)(src + (size_t)(k0 + kk) * ld + n0 + c4); gv[i] = gk ? gk[k0 + kk] : 1.0f; }
#pragma unroll
    for (int i = 0; i < 16; ++i) { const int kk = 4 * i + (lane >> 4), c4 = (lane & 15) * 4; const f32x4 w = v[i] * gv[i];
        scr[kk * 65 + c4 + 0] = w.x; scr[kk * 65 + c4 + 1] = w.y; scr[kk * 65 + c4 + 2] = w.z; scr[kk * 65 + c4 + 3] = w.w; }
    LDS_WAIT(); asm volatile("" ::: "memory");
    const int c = lane & 7;
#pragma unroll
    for (int j = 0; j < 8; ++j) { const int n = (lane >> 3) + 8 * j; const LAS float* s = scr + (8 * c) * 65 + n;
        v4u o; o.x = pk2(s[0 * 65], s[1 * 65]); o.y = pk2(s[2 * 65], s[3 * 65]); o.z = pk2(s[4 * 65], s[5 * 65]); o.w = pk2(s[6 * 65], s[7 * 65]);
        *(GAS v4u*)(dst + (size_t)n * Kd + k0 + 8 * c) = o; }
    LDS_WAIT(); asm volatile("" ::: "memory");
}

constexpr int CV_UP = 16 * 704, CV_DN = 8 * 704, CV_CIN = 2 * 768, CV_COUT = 2 * 256, CV_AIN = 2304, CV_AOUT = 256, CV_MIN = 896, CV_MOUT = 256;
constexpr int CV_O_DN = CV_UP, CV_O_CIN = CV_O_DN + CV_DN, CV_O_COUT = CV_O_CIN + CV_CIN, CV_O_ATT = CV_O_COUT + CV_COUT, CV_O_ML = CV_O_ATT + CV_AIN + CV_AOUT;
__device__ __forceinline__ void convert_range(Frame& F, const Args& a, int lo, int n, int wrank, int nw) {
    const LaneId li = lane_id();
    LAS float* scr = (LAS float*)(F.lds + li.wave * 16640);
    const int lane = li.lane;
    unsigned char* ws = F.ws;
    constexpr int N_UP = CV_UP, N_DN = CV_DN, N_CIN = CV_CIN, N_COUT = CV_COUT, N_AIN = CV_AIN, N_AOUT = CV_AOUT, N_MIN = CV_MIN;
    for (int it = lo + wrank; it < lo + n; it += nw) {
        int r = it; const float* src; int ld, K, kb, n0; bf16* dst; const float* gk = nullptr;
        if (r < N_UP) { const int mtx = r / 704; r -= mtx * 704; const int l = mtx >> 2, f = (mtx >> 1) & 1, which = mtx & 1;
            src = a.in[2 + 3 * f + which] + (size_t)l * D * FF; ld = FF; K = D; kb = r / 44; n0 = (r - kb * 44) * 64; gk = a.in[1] + (size_t)(l * 6 + 4 * f) * D;
            dst = (bf16*)(ws + WS_WUP) + (size_t)(l * 2 + f) * (2 * FF) * D + (size_t)(256 * (n0 >> 7) + (n0 & 127) + which * 128) * D; }
        else if ((r -= N_UP) < N_DN) { const int mtx = r / 704; r -= mtx * 704; const int l = mtx >> 1, f = mtx & 1;
            src = a.in[4 + 3 * f] + (size_t)l * FF * D; ld = D; K = FF; kb = r >> 4; n0 = (r & 15) * 64;
            dst = (bf16*)(ws + WS_WDN) + (size_t)(l * 2 + f) * D * FF + (size_t)n0 * FF; }
        else if ((r -= N_DN) < N_CIN) { const int j = r / 768; r -= j * 768;
            src = a.in[8] + (size_t)j * D * 3072; ld = 3072; K = D; kb = r / 48; n0 = (r - kb * 48) * 64; gk = a.in[1] + (size_t)((3 * j) * 6 + 2) * D;
            int drow = n0; if (n0 >= 2048) { const int f = n0 - 2048; drow = 1024 + 256 * (f >> 7) + 128 + (f & 127); } else if (n0 >= 1024) { const int f = n0 - 1024; drow = 1024 + 256 * (f >> 7) + (f & 127); }
            dst = (bf16*)(ws + WS_WCIN) + (size_t)j * 3072 * D + (size_t)drow * D; }
        else if ((r -= N_CIN) < N_COUT) { const int j = r >> 8; r &= 255;
            src = a.in[10] + (size_t)j * D * D; ld = D; K = D; kb = r >> 4; n0 = (r & 15) * 64;
            dst = (bf16*)(ws + WS_WCOUT) + (size_t)j * D * D + (size_t)n0 * D; }
        else if ((r -= N_COUT) < N_AIN) { src = a.in[11]; ld = 9216; K = D; kb = r / 144; n0 = (r - kb * 144) * 64; gk = a.in[1] + (size_t)(1 * 6 + 2) * D;
            dst = (bf16*)(ws + WS_WAIN) + (size_t)n0 * D; }
        else if ((r -= N_AIN) < N_AOUT) { src = a.in[12]; ld = D; K = D; kb = r >> 4; n0 = (r & 15) * 64;
            dst = (bf16*)(ws + WS_WAOUT) + (size_t)n0 * D; }
        else if ((r -= N_AOUT) < N_MIN) { src = a.in[13]; ld = ML_PROJ; K = D; kb = r / 56; const int gi = r - kb * 56; int drow; gk = a.in[1] + (size_t)(2 * 6 + 2) * D;
            if (gi < 16) { n0 = gi * 64; drow = n0; }
            else if (gi < 32) { n0 = 2048 + (gi - 16) * 64; drow = 1024 + (gi - 16) * 64; }
            else if (gi < 40) { n0 = 512 + (gi - 32) * 64; drow = 2048 + (gi - 32) * 64; }
            else { n0 = 1024 + (gi - 40) * 64; drow = 2560 + (gi - 40) * 64; }
            dst = (bf16*)(ws + WS_WMIN) + (size_t)drow * D; }
        else { r -= N_MIN; src = a.in[16]; ld = D; K = D; kb = r >> 4; n0 = (r & 15) * 64;
            dst = (bf16*)(ws + WS_WMOUT) + (size_t)n0 * D; }
        transpose_tile(src, ld, kb * 64, n0, dst, K, scr, lane, gk);
    }
}
__device__ __forceinline__ void convert_ffn(Frame& F, const Args& a, int l, int f, int wrank, int nw) {
    convert_range(F, a, (l * 4 + f * 2) * 704, 1408, wrank, nw); convert_range(F, a, CV_O_DN + (l * 2 + f) * 704, 704, wrank, nw);
}

__device__ __forceinline__ void prologue(Frame& F, const Args& a) {
    const LaneId li = lane_id();
    const int gw = F.vcu * NWAVES + li.wave, NGW = F.G * NWAVES, lane = li.lane;
    unsigned char* ws = F.ws;
    convert_range(F, a, 0, CV_O_ML + CV_MIN + CV_MOUT, gw, NGW);
    { const int gt = gw * 64 + lane;
      if (gt < SEQ * 8) { const int t = gt >> 3, i = gt & 7; const float inv = (float)exp(-((double)i / 8.0) * log(500000.0)); const float ang = (float)t * inv;
          float* tab = (float*)(ws + WS_ROPE); tab[t * 16 + i] = (float)cos((double)ang); tab[t * 16 + 8 + i] = (float)sin((double)ang); }
      if (gt < 8 * D) { const int j = gt >> 10, k = gt & 1023; ((float*)(ws + WS_GATEW))[gt] = a.in[13][(size_t)k * ML_PROJ + 3072 + j] * a.in[1][(size_t)(2 * 6 + 2) * D + k]; } }
    thin_phase(F, a.in[0], (bf16*)(ws + WS_XN), nullptr, nullptr, 0.f, (float*)(ws + WS_RS), nullptr, nullptr, nullptr);
}


typedef float f32x16 __attribute__((ext_vector_type(16)));
#define MFMA32(a, b, c) __builtin_amdgcn_mfma_f32_32x32x16_bf16((a), (b), (c), 0, 0, 0)
__device__ __forceinline__ bf16x8 as_frag(const v4u v) { return __builtin_bit_cast(bf16x8, v); }
__device__ __forceinline__ int pi32(int rho) { return (rho & ~12) | ((rho & 8) >> 1) | ((rho & 4) << 1); }
__device__ __forceinline__ v4u pack8(const float (&x)[8]) { v4u w; w.x = pg8::cvt_pk_bf16(x[0], x[1]); w.y = pg8::cvt_pk_bf16(x[2], x[3]); w.z = pg8::cvt_pk_bf16(x[4], x[5]); w.w = pg8::cvt_pk_bf16(x[6], x[7]); return w; }

__device__ __forceinline__ size_t ftr_off(int ftile, int p16, int slot) { return ((size_t)ftile * (M / 16) + p16) * 512 + slot * 8; }

__device__ __forceinline__ void attn_mfma(Frame& F, int g) {
    const int sh = 2 * g, L = SEQ >> sh, lt = 6 - sh;
    const bf16* QK = (const bf16*)(F.ws + WS_BIG); const bf16* VT = (const bf16*)(F.ws + WS_TR);
    bf16* OACC = (bf16*)(F.ws + WS_R2); float* LSE = (float*)(F.ws + WS_LSE);
    const LaneId li = lane_id(); const int lane = li.lane, r32 = lane & 31, hi = lane >> 5, pr = pi32(r32);
    const int gw = F.vcu * NWAVES + li.wave, NGW = F.G * NWAVES;
    for (int unit = gw; unit < BATCH * 16 * 64; unit += NGW) {
        const int bh = unit >> 6, t64 = unit & 63, b = bh >> 4, h = bh & 15;
        const int r = t64 >> lt, T = t64 & ((1 << lt) - 1);
        const size_t qrow = (size_t)(b << 11) + (size_t)(((32 * T + r32) << sh) + r);
        bf16x8 qf[4];
        { const GAS v4u* qp = (const GAS v4u*)(QK + (size_t)(((b * 64 + t64) * 16 + h) * 4) * 512 + (r32 + 32 * hi) * 8);
#pragma unroll
          for (int d0 = 0; d0 < 4; ++d0) qf[d0] = as_frag(qp[64 * d0]); }
        v4u kf[5][4];
#pragma unroll
        for (int j = 0; j < 5; ++j) { const int Tc = (T - 4 + j) < 0 ? 0 : (T - 4 + j);
            const GAS v4u* kp = (const GAS v4u*)(QK + (size_t)M * 1024 + (size_t)(((b * 64 + (r << lt) + Tc) * 16 + h) * 4) * 512 + (pr + 32 * hi) * 8);
#pragma unroll
            for (int d0 = 0; d0 < 4; ++d0) kf[j][d0] = kp[64 * d0]; }
        float lp = 0.f; if (g > 0) lp = LSE[qrow * 16 + h];
        f32x16 sc[5];
#pragma unroll
        for (int j = 0; j < 5; ++j) { f32x16 a;
#pragma unroll
            for (int i = 0; i < 16; ++i) a[i] = 0.f;
#pragma unroll
            for (int d0 = 0; d0 < 4; ++d0) a = MFMA32(as_frag(kf[j][d0]), qf[d0], a);
            sc[j] = a; }
        v4u vf[5][2][2];
#pragma unroll
        for (int j = 0; j < 5; ++j) { const int Tc = (T - 4 + j) < 0 ? 0 : (T - 4 + j);
#pragma unroll
            for (int db = 0; db < 2; ++db) { const int p16 = ((b << 11) + r * L + 32 * Tc) >> 4;
#pragma unroll
                for (int s = 0; s < 2; ++s) vf[j][db][s] = *(const GAS v4u*)(VT + ftr_off(2 * h + db, p16 + s, pr + 32 * hi)); } }
#pragma unroll
        for (int j = 0; j < 4; ++j) if ((T - 4 + j) < 0) {
#pragma unroll
            for (int i = 0; i < 16; ++i) sc[j][i] = -INFINITY; }
#pragma unroll
        for (int i = 0; i < 16; ++i) { const int kl = 16 * (i >> 3) + 8 * hi + (i & 7);
            sc[0][i] = (kl >= r32) ? sc[0][i] : -INFINITY; sc[4][i] = (kl <= r32) ? sc[4][i] : -INFINITY; }
        float mx = -INFINITY;
#pragma unroll
        for (int j = 0; j < 5; ++j)
#pragma unroll
            for (int i = 0; i < 16; i += 2) mx = fmaxf(fmaxf(mx, sc[j][i]), sc[j][i + 1]);
        mx = fmaxf(mx, __shfl_xor(mx, 32));
        float ls = 0.f; v4u pf[5][2];
#pragma unroll
        for (int j = 0; j < 5; ++j)
#pragma unroll
            for (int s = 0; s < 2; ++s) { float p[8];
#pragma unroll
                for (int e = 0; e < 8; ++e) { p[e] = __builtin_amdgcn_exp2f(sc[j][8 * s + e] - mx); ls += p[e]; }
                pf[j][s] = pack8(p); }
        ls += __shfl_xor(ls, 32);
        f32x16 o[2];
#pragma unroll
        for (int db = 0; db < 2; ++db)
#pragma unroll
            for (int i = 0; i < 16; ++i) o[db][i] = 0.f;
#pragma unroll
        for (int j = 0; j < 5; ++j)
#pragma unroll
            for (int db = 0; db < 2; ++db)
#pragma unroll
                for (int s = 0; s < 2; ++s) o[db] = MFMA32(as_frag(vf[j][db][s]), as_frag(pf[j][s]), o[db]);
        float inv = 1.f / ls, lse = mx + log2f(ls), wprev = 0.f;
        if (g > 0) { const float mm = fmaxf(lp, lse), e1 = exp2f(lp - mm), e2 = exp2f(lse - mm), den = e1 + e2;
            wprev = e1 / den; inv *= e2 / den; lse = mm + log2f(den); }
#pragma unroll
        for (int db = 0; db < 2; ++db)
#pragma unroll
            for (int s = 0; s < 2; ++s) { GAS v4u* op = (GAS v4u*)(OACC + qrow * LDX + h * 64 + 32 * db + 16 * s + 8 * hi); float x[8];
#pragma unroll
                for (int e = 0; e < 8; ++e) x[e] = o[db][8 * s + e] * inv;
                if (g > 0) { const v4u pv = *op;
#pragma unroll
                    for (int e = 0; e < 8; ++e) x[e] += wprev * bfel(pv, e); }
                *op = pack8(x); }
        if (hi == 0) LSE[qrow * 16 + h] = lse;
    }
}


__device__ __forceinline__ void mlstm_gate_prepass(Frame& F, const float* b_i, const float* b_f) {
    const float* GATES = (const float*)(F.ws + WS_GATES); float* GV = (float*)(F.ws + WS_GV);
    const LaneId li = lane_id(); const int lane = li.lane, gw = F.vcu * NWAVES + li.wave, NGW = F.G * NWAVES;
    for (int item = gw; item < 1024; item += NGW) {
        const int bh = item >> 5, c = item & 31, b = bh >> 2, h = bh & 3; const int tok = (b << 11) + c * 64 + lane;
        const float ig = GATES[(size_t)tok * 8 + h] + b_i[h]; const float lf = logsigmoid_f(GATES[(size_t)tok * 8 + 4 + h] + b_f[h]);
        const float bc = wave_incl_sum(lf, lane); const float u = ig - bc; const float run = wave_incl_max(u, lane);
        GV[(size_t)item * 192 + lane] = bc; GV[(size_t)item * 192 + 64 + lane] = u; GV[(size_t)item * 192 + 128 + lane] = run;
    }
}

__device__ __forceinline__ void mlstm_S_mfma(Frame& F) {
    const bf16* KVT = (const bf16*)(F.ws + WS_TR);
    bf16* CST = (bf16*)(F.ws + WS_R2); float* NST = (float*)(F.ws + WS_NST); float* MST = (float*)(F.ws + WS_MST); const float* GV = (const float*)(F.ws + WS_GV);
    const LaneId li = lane_id(); const int lane = li.lane, r32 = lane & 31, hi = lane >> 5, pr = pi32(r32), dvs = li.wave;
    LAS float* wsl = (LAS float*)(F.lds + li.wave * 512);
    for (int item = F.vcu; item < 128; item += F.G) {
        const int bh = item >> 2, dqt = item & 3, b = bh >> 2, h = bh & 3;
        f32x16 acc;
#pragma unroll
        for (int i = 0; i < 16; ++i) acc[i] = 0.f;
        float nacc = 0.f;
        const float bt_l = GV[(size_t)(bh * 32 + r32) * 192 + 63], am_l = GV[(size_t)(bh * 32 + r32) * 192 + 128 + 63];
        float marr = 0.f;
        { float m = 0.f;
          for (int c = 0; c < 32; ++c) { if (r32 == c) marr = m; m = __shfl(bt_l, c) + fmaxf(m, __shfl(am_l, c)); } }
        const GAS bf16* kTrow = (const GAS bf16*)KVT + ftr_off(4 * h + dqt, (b << 11) >> 4, pr + 32 * hi);
        const GAS bf16* vTrow = (const GAS bf16*)KVT + ftr_off(16 + 8 * h + dvs, (b << 11) >> 4, r32 + 32 * hi);
        v4u kfn[4], vrn[4]; float un;
#pragma unroll
        for (int ks = 0; ks < 4; ++ks) { kfn[ks] = *(const GAS v4u*)(kTrow + 512 * ks); vrn[ks] = *(const GAS v4u*)(vTrow + 512 * ks); }
        un = GV[(size_t)(bh * 32) * 192 + 64 + lane];
        for (int c = 0; c < 32; ++c) {
            const size_t sidx = (size_t)(bh * 32 + c);
            v4u kfc[4], vrc[4]; const float uc = un;
#pragma unroll
            for (int ks = 0; ks < 4; ++ks) { kfc[ks] = kfn[ks]; vrc[ks] = vrn[ks]; }
            { const int cn = c < 31 ? c + 1 : 31;
#pragma unroll
              for (int ks = 0; ks < 4; ++ks) { kfn[ks] = *(const GAS v4u*)(kTrow + (4 * cn + ks) * 512); vrn[ks] = *(const GAS v4u*)(vTrow + (4 * cn + ks) * 512); }
              un = GV[(size_t)(bh * 32 + cn) * 192 + 64 + lane]; }
#pragma unroll
            for (int s = 0; s < 2; ++s) { float x[8];
#pragma unroll
                for (int e = 0; e < 8; ++e) x[e] = acc[8 * s + e];
                *(GAS v4u*)(CST + (((sidx * 8 + dvs) * 4 + dqt) * 2 + s) * 512 + lane * 8) = pack8(x); }
            if (dvs == 0 && hi == 0) NST[sidx * 128 + 32 * dqt + pr] = nacc;
            const float m_prev = __shfl(marr, c), btot = __shfl(bt_l, c), m_new = btot + fmaxf(m_prev, __shfl(am_l, c));
            if (dvs == 0 && dqt == 0 && lane == 0) MST[sidx] = m_prev;
            const float we = expf(uc + btot - m_new); const float decay = expf(btot + m_prev - m_new);
            wsl[lane] = we;
            LDS_WAIT(); __builtin_amdgcn_wave_barrier();
#pragma unroll
            for (int i = 0; i < 16; ++i) acc[i] *= decay;
            float nsum = 0.f;
#pragma unroll
            for (int ks = 0; ks < 4; ++ks) {
                const v4u kf = kfc[ks]; const v4u vr = vrc[ks];
                const f32x4 w0 = *(const LAS f32x4*)(wsl + 16 * ks + 8 * hi), w1 = *(const LAS f32x4*)(wsl + 16 * ks + 8 * hi + 4);
                float x[8];
#pragma unroll
                for (int e = 0; e < 8; ++e) { const float w = (e < 4) ? w0[e & 3] : w1[e & 3]; x[e] = bfel(vr, e) * w; nsum += bfel(kf, e) * w; }
                acc = MFMA32(as_frag(kf), as_frag(pack8(x)), acc);
            }
            nsum += __shfl_xor(nsum, 32);
            nacc = decay * nacc + nsum;
            LDS_WAIT(); __builtin_amdgcn_wave_barrier();
        }
    }
}

__device__ __forceinline__ void mlstm_O_mfma(Frame& F) {
    const bf16* QKO = (const bf16*)(F.ws + WS_BIG); const bf16* KVT = (const bf16*)(F.ws + WS_TR);
    const bf16* CST = (const bf16*)(F.ws + WS_R2); const float* NST = (const float*)(F.ws + WS_NST); const float* MST = (const float*)(F.ws + WS_MST); const float* GV = (const float*)(F.ws + WS_GV);
    bf16* HOG = (bf16*)(F.ws + WS_BIG) + (size_t)M * 1024;
    const LaneId li = lane_id(); const int lane = li.lane, r32 = lane & 31, hi = lane >> 5, pr = pi32(r32), th = li.wave >> 2, dvq = li.wave & 3;
    LAS float* gl = (LAS float*)(F.lds + li.wave * 2048);
    constexpr float LOG2E = 1.4426950408889634f;
    for (int item = F.vcu; item < 1024; item += F.G) {
        const int bh = item >> 5, c = item & 31, b = bh >> 2, h = bh & 3; const int tok0 = (b << 11) + c * 64;
        const int t = 32 * th + r32;
        const float g_bc = GV[(size_t)item * 192 + lane], g_u = GV[(size_t)item * 192 + 64 + lane], g_run = GV[(size_t)item * 192 + 128 + lane];
        const float m_prev = ld_f32_coherent(MST + item);
        const float n_lo = NST[(size_t)item * 128 + lane], n_hi = NST[(size_t)item * 128 + 64 + lane];
        v4u cfr[2][8];
        { const GAS v4u* cp = (const GAS v4u*)(CST + (((size_t)item * 8 + 2 * dvq) * 8) * 512 + (pr + 32 * hi) * 8);
#pragma unroll
          for (int ks = 0; ks < 8; ++ks) cfr[0][ks] = cp[64 * ks]; }
        bf16x8 qf[8];
        { const GAS v4u* qp = (const GAS v4u*)(QKO + (size_t)((((tok0 >> 5) + th) * 4 + h) * 8) * 512 + (r32 + 32 * hi) * 8);
#pragma unroll
          for (int ks = 0; ks < 8; ++ks) qf[ks] = as_frag(qp[64 * ks]); }
        v4u kfr[2][8];
#pragma unroll
        for (int st = 0; st < 2; ++st) { const GAS v4u* kp = (const GAS v4u*)(QKO + (size_t)M * 512 + (size_t)((((tok0 >> 5) + st) * 4 + h) * 8) * 512 + (pr + 32 * hi) * 8);
#pragma unroll
            for (int ks = 0; ks < 8; ++ks) kfr[st][ks] = kp[64 * ks]; }
        { const float mt = g_bc + fmaxf(m_prev, g_run);
          gl[lane] = g_u * LOG2E; gl[64 + lane] = (g_bc - mt) * LOG2E; gl[128 + lane] = expf(g_bc + m_prev - mt); gl[192 + lane] = expf(-mt); gl[256 + lane] = n_lo; gl[320 + lane] = n_hi; }
        __builtin_amdgcn_wave_barrier();
        const float e2 = gl[64 + t], wit = gl[128 + t], emt = gl[192 + t];
        f32x16 sacc[2];
#pragma unroll
        for (int st = 0; st < 2; ++st) { f32x16 a;
#pragma unroll
            for (int i = 0; i < 16; ++i) a[i] = 0.f;
            if (st <= th) {
#pragma unroll
                for (int ks = 0; ks < 8; ++ks) a = MFMA32(as_frag(kfr[st][ks]), qf[ks], a);
            }
            sacc[st] = a; }
        { const GAS v4u* cp = (const GAS v4u*)(CST + (((size_t)item * 8 + 2 * dvq + 1) * 8) * 512 + (pr + 32 * hi) * 8);
#pragma unroll
          for (int ks = 0; ks < 8; ++ks) cfr[1][ks] = cp[64 * ks]; }
        v4u vfr[2][4];
#pragma unroll
        for (int dt = 0; dt < 2; ++dt) { const GAS v4u* vp = (const GAS v4u*)(KVT + ftr_off(16 + 8 * h + 2 * dvq + dt, tok0 >> 4, pr + 32 * hi));
#pragma unroll
            for (int j = 0; j < 4; ++j) vfr[dt][j] = vp[64 * j]; }
        v4u ogv[2][2];
#pragma unroll
        for (int dt = 0; dt < 2; ++dt)
#pragma unroll
            for (int s2 = 0; s2 < 2; ++s2) ogv[dt][s2] = *(const GAS v4u*)(HOG + (size_t)(tok0 + t) * 1024 + (size_t)h * 256 + 64 * dvq + 32 * dt + 16 * s2 + 8 * hi);
        float dsum = 0.f; v4u af[2][2];
#pragma unroll
        for (int st = 0; st < 2; ++st)
#pragma unroll
            for (int s2 = 0; s2 < 2; ++s2) { float x[8];
#pragma unroll
                for (int e = 0; e < 8; ++e) { const int sl = 16 * s2 + 8 * hi + e; const float w = __builtin_amdgcn_exp2f(e2 + gl[32 * st + sl]);
                    const bool ok = (st < th) || (st == th && sl <= r32); x[e] = ok ? sacc[st][8 * s2 + e] * w : 0.f; dsum += x[e]; }
                af[st][s2] = pack8(x); }
        dsum += __shfl_xor(dsum, 32);
        float nq = 0.f;
#pragma unroll
        for (int ks = 0; ks < 8; ++ks) { const f32x4 n0 = *(const LAS f32x4*)(gl + 256 + 16 * ks + 8 * hi), n1 = *(const LAS f32x4*)(gl + 256 + 16 * ks + 8 * hi + 4);
            const v4u qv = __builtin_bit_cast(v4u, qf[ks]);
            nq += n0.x * bflo(qv.x) + n0.y * bfhi(qv.x) + n0.z * bflo(qv.y) + n0.w * bfhi(qv.y) + n1.x * bflo(qv.z) + n1.y * bfhi(qv.z) + n1.z * bflo(qv.w) + n1.w * bfhi(qv.w); }
        nq += __shfl_xor(nq, 32);
        const float den = dsum + wit * nq; const float inv = 1.f / fmaxf(fabsf(den), emt);
        f32x16 hacc[2];
#pragma unroll
        for (int dt = 0; dt < 2; ++dt) { f32x16 a;
#pragma unroll
            for (int i = 0; i < 16; ++i) a[i] = 0.f;
#pragma unroll
            for (int ks = 0; ks < 8; ++ks) a = MFMA32(as_frag(cfr[dt][ks]), qf[ks], a);
#pragma unroll
            for (int i = 0; i < 16; ++i) a[i] *= wit;
#pragma unroll
            for (int st = 0; st < 2; ++st)
                if (st <= th) {
#pragma unroll
                    for (int s2 = 0; s2 < 2; ++s2) a = MFMA32(as_frag(vfr[dt][2 * st + s2]), as_frag(af[st][s2]), a);
                }
            hacc[dt] = a; }
#pragma unroll
        for (int dt = 0; dt < 2; ++dt)
#pragma unroll
            for (int s2 = 0; s2 < 2; ++s2) { float x[8];
#pragma unroll
                for (int e = 0; e < 8; ++e) x[e] = hacc[dt][8 * s2 + e] * inv * __builtin_amdgcn_rcpf(1.f + __builtin_amdgcn_exp2f(-LOG2E * bfel(ogv[dt][s2], e)));
                *(GAS v4u*)(HOG + (size_t)(tok0 + t) * 1024 + (size_t)h * 256 + 64 * dvq + 32 * dt + 16 * s2 + 8 * hi) = pack8(x); }
        __builtin_amdgcn_wave_barrier();
    }
}

#ifndef PROBE_PROLOGUE
#define PROBE_PROLOGUE 1
#endif
#ifndef PROBE_GEMM
#define PROBE_GEMM 1
#endif
#ifndef PROBE_THIN
#define PROBE_THIN 0
#endif
#ifndef PROBE_ATT0
#define PROBE_ATT0 0
#endif
#ifndef PROBE_MLS
#define PROBE_MLS 1
#endif
#ifndef PROBE_MLO
#define PROBE_MLO 1
#endif
#ifndef PROBE_UP
#define PROBE_UP 1
#endif
#ifndef PROBE_DOWN
#define PROBE_DOWN 1
#endif
#ifndef PROBE_BAR
#define PROBE_BAR 1
#endif
#ifndef MK_SPLIT
#define MK_SPLIT 0
#endif
constexpr int N_PHASE_IDS = 1 + 8 * 12;
__host__ __device__ inline bool phase_nonempty(int id) {
    if (id == 0) return true;
    const int s = (id - 1) >> 3, k = (id - 1) & 7, sub = s % 3, mix = (s / 3) % 3;
    if (k >= 6) return true;
    if (sub != 1) return k == 0;
    if (mix == 0) return k <= 1;
    if (mix == 1) return k <= 5;
    return k <= 2;
}

__global__ void __launch_bounds__(NWAVES * 64, 2) mk_fwd(Args args) {
    extern __shared__ __attribute__((aligned(16))) unsigned char lds[];
    Frame F;
    F.lds = (LAS unsigned char*)lds;
    F.MISC = (volatile LAS unsigned*)(F.lds + MISC_OFF);
    F.G = gridDim.x; { const int bx = blockIdx.x; F.vcu = (F.G % 8 == 0) ? (bx % 8) * (F.G / 8) + bx / 8 : bx; }
    F.ws = args.ws; F.ctl = (gu32*)(args.ws + WS_CTL);
    unsigned char* ws = args.ws;
    for (int u = threadIdx.x; u < (LDS_BYTES - MISC_OFF) / 4; u += NWAVES * 64) ((LAS unsigned*)(F.lds + MISC_OFF))[u] = 0u;
    __syncthreads();
#if MK_SPLIT
    const int lo = args.ph_lo, hi = args.ph_hi;
    int pid = 0;
#define RUN(k) ((pid = (k)), (lo <= pid && pid < hi))
#define SEAM() do { } while (0)
#else
    (void)xcd_barrier_post((unsigned*)(F.ctl + CW_BAR), F.MISC + 8);
    int pid = 0;
#define RUN(k) ((pid = (k)), true)
#define SEAM() do { if (pid + 1 < N_PHASE_IDS) { for (int pb_ = 0; pb_ < PROBE_BAR; ++pb_) { XcdBarrier bar_; bar_.bar = (unsigned*)(F.ctl + CW_BAR); bar_.x = xb_xcc_id(); bar_.st = F.MISC + 8; xcd_barrier(bar_); } } } while (0)
#endif

    bf16* const XN = (bf16*)(ws + WS_XN); bf16* const BIG = (bf16*)(ws + WS_BIG); bf16* const Y = (bf16*)(ws + WS_Y); bf16* const R2 = (bf16*)(ws + WS_R2);
    const float* const rope = (const float*)(ws + WS_ROPE);

    if (RUN(0)) { for (int pp_ = 0; pp_ < PROBE_PROLOGUE; ++pp_) prologue(F, args); SEAM(); }

    for (int s = 0; s < 12; ++s) {
        const int layer = s / 3, sub = s - 3 * layer, mix = layer % 3, mj = layer / 3, base = 1 + 8 * s;
        const bool is_ffn = (sub != 1);
        const int nrep = (!is_ffn && mix == 1) ? 3 : 1;
        for (int rep = 0; rep < nrep; ++rep) {
            if (RUN(base + 2 * rep)) {
                if (!is_ffn && mix == 2) mlstm_gate_prepass(F, args.in[14] + mj * 4, args.in[15] + mj * 4);
                {   pg8::Gemm g; pg8::EpiX E;
                    g.A = XN; g.M = M; g.K = D; g.lda = LDX; g.ldb = D; g.bdil = 1; E.O = BIG; E.O2 = nullptr; E.rope = rope; E.qscale = 1.f; E.rs = (const float*)(ws + WS_RS); E.rsm = 1; E.cdil = 1; E.gsh = 0;
                    if (is_ffn) { g.Bt = (const bf16*)(ws + WS_WUP) + (size_t)(layer * 2 + (sub >> 1)) * (2 * FF) * D; g.N = 2 * FF; E.mode = 1; E.ldc = FF; }
                    else if (mix == 0) { g.Bt = (const bf16*)(ws + WS_WCIN) + (size_t)mj * 3072 * D; g.N = 3072; E.mode = 2; E.ldc = 1024; E.O2 = BIG + (size_t)M * 1024; }
                    else if (mix == 1) { g.Bt = (const bf16*)(ws + WS_WAIN) + (size_t)(rep * 3072) * D; g.N = 2048; E.mode = 3; E.ldc = LDQ; E.qscale = ATT_QSCALE; E.gsh = 2 * rep; }
                    else { g.Bt = (const bf16*)(ws + WS_WMIN); g.N = 2048; E.mode = 4; E.ldc = LDQ; E.qscale = ML_QSCALE; E.O2 = BIG + (size_t)M * 1024; }
                    pg8::StaticOrder S; S.init(g.M, g.N, F.G, (int)blockIdx.x); for (int pg_ = 0; pg_ < (is_ffn ? PROBE_UP : 1) * PROBE_GEMM; ++pg_) pg8::gemm_phase<pg8::EpiX, pg8::StaticOrder>(F.lds + RING_OFF, g, S, E); }
                if (!is_ffn && mix != 0) {
                    pg8::Gemm g; pg8::EpiX E;
                    g.Bt = XN; g.N = M; g.K = D; g.lda = D; g.ldb = LDX; E.mode = 0; E.O = (bf16*)(ws + WS_TR); E.ldc = M; E.O2 = nullptr; E.rope = rope; E.qscale = 1.f; E.rs = (const float*)(ws + WS_RS); E.rsm = 2; E.cdil = 1; E.gsh = 0;
                    if (mix == 1) { g.A = (const bf16*)(ws + WS_WAIN) + (size_t)(rep * 3072 + 2048) * D; g.M = 1024; g.bdil = 1 << (2 * rep); E.cdil = g.bdil; }
                    else { g.A = (const bf16*)(ws + WS_WMIN) + (size_t)2048 * D; g.M = 1536; g.bdil = 1; }
                    pg8::StaticOrder S; S.init(g.M, g.N, F.G, (int)blockIdx.x); for (int pg_ = 0; pg_ < PROBE_GEMM; ++pg_) pg8::gemm_phase<pg8::EpiX, pg8::StaticOrder>(F.lds + RING_OFF, g, S, E); }
                SEAM();
            }
            if (!is_ffn && RUN(base + 2 * rep + 1)) {
                if (mix == 0) conv_phase(F, BIG, BIG + (size_t)M * 1024, args.in[9] + (size_t)mj * 3 * D);
                else if (mix == 1) { if (rep == 0) for (int pa_ = 0; pa_ < PROBE_ATT0; ++pa_) attn_mfma(F, 0); attn_mfma(F, rep); }
                else for (int ps_ = 0; ps_ < PROBE_MLS; ++ps_) mlstm_S_mfma(F);
                SEAM();
            }
        }
        if (!is_ffn && mix == 2 && RUN(base + 2)) { for (int po_ = 0; po_ < PROBE_MLO; ++po_) mlstm_O_mfma(F); SEAM(); }
        if (RUN(base + 6)) {
            pg8::Gemm g; g.M = M; g.N = D; g.bdil = 1; g.K = D; g.lda = D; g.ldb = D;
            if (is_ffn) { g.A = BIG; g.K = FF; g.lda = FF; g.ldb = FF; g.Bt = (const bf16*)(ws + WS_WDN) + (size_t)(layer * 2 + (sub >> 1)) * D * FF; }
            else if (mix == 0) { g.A = BIG; g.Bt = (const bf16*)(ws + WS_WCOUT) + (size_t)mj * D * D; }
            else if (mix == 1) { g.A = R2; g.lda = LDX; g.Bt = (const bf16*)(ws + WS_WAOUT); }
            else { g.A = BIG + (size_t)M * 1024; g.lda = D; g.Bt = (const bf16*)(ws + WS_WMOUT); }
            pg8::EpiX E; E.mode = 0; E.O = Y; E.ldc = D; E.O2 = nullptr; E.rope = rope; E.qscale = 1.f; E.rs = nullptr; E.rsm = 0; E.cdil = 1; E.gsh = 0;
            pg8::StaticOrder S; S.init(g.M, g.N, F.G, (int)blockIdx.x);
            for (int pg_ = 0; pg_ < (is_ffn ? PROBE_DOWN : 1) * PROBE_GEMM; ++pg_) pg8::gemm_phase<pg8::EpiX, pg8::StaticOrder>(F.lds + RING_OFF, g, S, E);
            SEAM();
        }
        if (RUN(base + 7)) {
            const float* gpost = args.in[1] + (size_t)(layer * 6 + 2 * sub + 1) * D;
            const bool last = (s == 11); const bool want_gates = (sub == 0 && mix == 2);
            for (int pt_ = 0; pt_ < PROBE_THIN; ++pt_) thin_phase(F, nullptr, XN, Y, gpost, 0.f, (float*)(ws + WS_RS), nullptr, nullptr, nullptr);
            thin_phase(F, nullptr, XN, Y, gpost, is_ffn ? 0.5f : 1.0f, (float*)(ws + WS_RS), last ? args.out : nullptr, want_gates ? (const float*)(ws + WS_GATEW) : nullptr, (float*)(ws + WS_GATES));
            SEAM();
        }
    }
#undef RUN
#undef SEAM
}

extern "C" void kernel_launch(void* const* d_in, const int* in_sizes, int n_in, void* d_out, int out_size, void* d_ws, size_t ws_size, hipStream_t stream) {
    static int grid = 0;
    if (grid == 0) {
        if (n_in != 17 || in_sizes[0] != M * D || out_size != M * D || ws_size < WS_END) { fprintf(stderr, "kernel_launch: unexpected shapes (n_in %d, in0 %d, out %d, ws %zu < %zu); nothing launched\n", n_in, n_in > 0 ? in_sizes[0] : -1, out_size, ws_size, (size_t)WS_END); grid = -1; return; }
        int dev = 0, cus = 0, per_cu = 0;
        if (hipGetDevice(&dev) != hipSuccess || hipDeviceGetAttribute(&cus, hipDeviceAttributeMultiprocessorCount, dev) != hipSuccess) { grid = -1; return; }
        if (hipFuncSetAttribute((const void*)mk_fwd, hipFuncAttributeMaxDynamicSharedMemorySize, LDS_BYTES) != hipSuccess) { fprintf(stderr, "kernel_launch: hipFuncSetAttribute failed\n"); grid = -1; return; }
        if (hipOccupancyMaxActiveBlocksPerMultiprocessor(&per_cu, (const void*)mk_fwd, NWAVES * 64, LDS_BYTES) != hipSuccess || per_cu < 1)
            fprintf(stderr, "kernel_launch: note: occupancy query reports %d workgroups per CU\n", per_cu);
        (void)hipGetLastError();
        grid = cus;
    }
    if (grid < 0) return;
    if (hipMemsetAsync((char*)d_ws + WS_CTL, 0, CTL_ZERO_BYTES, stream) != hipSuccess) return;
    Args a{};
    for (int i = 0; i < 17; ++i) a.in[i] = (const float*)d_in[i];
    a.out = (float*)d_out; a.ws = (unsigned char*)d_ws;
#if MK_SPLIT
    for (int id = 0; id < N_PHASE_IDS; ++id) { if (!phase_nonempty(id)) continue; a.ph_lo = id; a.ph_hi = id + 1;
        hipLaunchKernelGGL(mk_fwd, dim3(grid), dim3(NWAVES * 64), LDS_BYTES, stream, a); }
#else
    a.ph_lo = 0; a.ph_hi = N_PHASE_IDS;
    hipLaunchKernelGGL(mk_fwd, dim3(grid), dim3(NWAVES * 64), LDS_BYTES, stream, a);
#endif
    const hipError_t le = hipPeekAtLastError();
    if (le != hipSuccess) fprintf(stderr, "kernel_launch: launch failed: %s\n", hipGetErrorName(le));
}
```

```cpp
#include <hip/hip_runtime.h>
#include <cstdio>
#include <cstdint>
#include <cmath>
namespace pg8 {
#define PG8_LAS __attribute__((address_space(3)))
typedef unsigned short bf16_t;
typedef short bf16x8 __attribute__((ext_vector_type(8)));
typedef float f32x4 __attribute__((ext_vector_type(4)));
typedef unsigned u32x4 __attribute__((ext_vector_type(4)));
constexpr int BM = 256, BK = 64, HALF = 128, HTB = HALF * BK * 2  , STAGE_BYTES = 8 * HTB, NXCD = 8, WGM = 8;

__host__ __device__ __forceinline__ int lds_byte(int r, int c) { const int st = (r >> 4) * 2 + (c >> 5), rr = r & 15, cc = c & 31, ob = rr * 64 + cc * 2; return st * 1024 + (ob ^ (((ob >> 9) & 1) << 5)); }
__host__ __device__ __forceinline__ void stage_rc(int b, int& R, int& C) { const int st = b / 1024, sb = b % 1024, swz = sb ^ (((sb >> 9) & 1) << 5); R = (st >> 1) * 16 + swz / 64; C = (st & 1) * 32 + (swz % 64) / 2; }
__host__ __device__ __forceinline__ int perm32(int rho) { const int n = rho >> 4, i = rho & 15; return 8 * (i >> 2) + 4 * n + (i & 3); }

struct Unit { int pm, pn; };
struct StaticOrder {
    int nM, nN, nwg, G, c;
    __host__ __device__ void init(int M, int N, int G_, int c_) { nM = M / BM; nN = N / BM; nwg = nM * nN; G = G_; c = c_; }
    __host__ __device__ bool next(int i, Unit& u) const {
        const long L = (long)i * G + c; if (L >= nwg) return false;
        int wgid = (int)L; { const int q = nwg / NXCD, r = nwg % NXCD, xcd = wgid % NXCD, off = wgid / NXCD; wgid = (xcd < r ? xcd * (q + 1) : r * (q + 1) + (xcd - r) * q) + off; }
        const int nig = WGM * nN, gid = wgid / nig, fm = gid * WGM, gsz = (nM - fm) < WGM ? (nM - fm) : WGM;
        u.pm = fm + ((wgid % nig) % gsz); u.pn = (wgid % nig) / gsz; return true;
    }
    __device__ __forceinline__ void a_ready(const Unit&) const {}
    __device__ __forceinline__ void done(const Unit&) const {}
};
__device__ __forceinline__ unsigned cvt_pk_bf16(float lo, float hi) { unsigned r; asm volatile("v_cvt_pk_bf16_f32 %0, %1, %2" : "=v"(r) : "v"(lo), "v"(hi)); return r; }
typedef float f32x2 __attribute__((ext_vector_type(2)));

struct Gemm { const bf16_t* A; const bf16_t* Bt; int M, N, K, lda, ldb, bdil; };

__device__ __forceinline__ unsigned b_half_off(const Gemm& g, int pn, int h) {
    const int p0 = pn * BM + h * HALF; int row = p0;
    if (g.bdil != 1) { const int L = 2048 / g.bdil, b = p0 >> 11, pp = p0 & 2047, r = pp / L, u0 = pp - r * L; row = (b << 11) + u0 * g.bdil + r; }
    return (unsigned)row * (unsigned)g.ldb * 2u;
}

__device__ __forceinline__ f32x4 silu4(f32x4 v) {
    f32x4 o;
#pragma unroll
    for (int i = 0; i < 4; ++i) { const float e = __builtin_amdgcn_exp2f(v[i] * -1.4426950408889634f); o[i] = v[i] * __builtin_amdgcn_rcpf(1.0f + e); }
    return o;
}

struct EpiX {
    static constexpr bool PERM = true;
    int mode; bf16_t* O; int ldc; bf16_t* O2; const float* rope; float qscale;
    const float* rs; int rsm, cdil, gsh;
    __device__ __forceinline__ void store8(__amdgpu_buffer_rsrc_t rsrc, const bf16_t* p, const f32x4 v0, const f32x4 v1) const {
        u32x4 w; w.x = cvt_pk_bf16(v0[0], v0[1]); w.y = cvt_pk_bf16(v0[2], v0[3]); w.z = cvt_pk_bf16(v1[0], v1[1]); w.w = cvt_pk_bf16(v1[2], v1[3]);
        __builtin_amdgcn_raw_buffer_store_b128(w, rsrc, (int)((const char*)p - (const char*)O), 0, 16); }
    __device__ __forceinline__ void operator()(const f32x4 (&acc)[2][2][4][2], const Unit& u, int wr, int wc, int fr, int fq, const PG8_LAS float* rsl) const {
        const int row0 = u.pm * BM + wr * 64 + fr;
        const __amdgpu_buffer_rsrc_t rsrc = __builtin_amdgcn_make_buffer_rsrc((void*)O, 0, 0x7fffffff, 0x00020000);
        const bool pair = (mode == 1) || (mode == 2 && u.pn >= 4);
        if (pair) {
            bf16_t* base = (mode == 1) ? O : O2; const int pnn = (mode == 1) ? u.pn : u.pn - 4; const int ld = (mode == 1) ? ldc : 1024;
            const int col0 = pnn * HALF + wc * 32 + 8 * fq;
#pragma unroll
            for (int ai = 0; ai < 2; ++ai)
#pragma unroll
                for (int m = 0; m < 4; ++m) { const int row = row0 + ai * HALF + m * 16; bf16_t* rowp = base + (size_t)row * ld + col0; const float rsc = rsl[row - u.pm * BM], r2 = rsc * rsc;
                    const f32x4 a0 = acc[ai][0][m][0], a1 = acc[ai][0][m][1], b0 = acc[ai][1][m][0], b1 = acc[ai][1][m][1];
                    f32x4 o0 = (a0 * b0) * r2, o1 = (a1 * b1) * r2;
                    if (mode == 1) { const float k2 = -1.4426950408889634f * rsc; const f32x4 t0 = a0 * k2, t1 = a1 * k2; f32x4 e0, e1;
#pragma unroll
                        for (int i = 0; i < 4; ++i) { e0[i] = __builtin_amdgcn_exp2f(t0[i]); e1[i] = __builtin_amdgcn_exp2f(t1[i]); }
                        e0 = e0 + 1.0f; e1 = e1 + 1.0f;
#pragma unroll
                        for (int i = 0; i < 4; ++i) { e0[i] = __builtin_amdgcn_rcpf(e0[i]); e1[i] = __builtin_amdgcn_rcpf(e1[i]); }
                        o0 = o0 * e0; o1 = o1 * e1; }
                    store8(rsrc, rowp, o0, o1); }
        } else {
            const int col0 = u.pn * BM + wc * 32 + 8 * fq;
            float sc = 1.f; bool dorope = false;
            if (mode == 3) { if (u.pn < 4) sc = qscale; dorope = ((wc & 1) == 0); }
            if (mode == 4) { if (u.pn < 2) sc = qscale; }
            f32x4 cs[2][2];
#pragma unroll
            for (int bj = 0; bj < 2; ++bj) { cs[bj][0] = (f32x4){1.f, 1.f, 1.f, 1.f}; cs[bj][1] = cs[bj][0]; }
            if (rsm == 2) {
#pragma unroll
                for (int bj = 0; bj < 2; ++bj) { const int p0 = col0 + bj * HALF; int t0 = p0, st = 1;
                    if (cdil != 1) { const int L = 2048 / cdil, bb = p0 >> 11, pp = p0 & 2047, r = pp / L, u0 = pp - r * L; t0 = (bb << 11) + u0 * cdil + r; st = cdil; }
#pragma unroll
                    for (int e = 0; e < 4; ++e) { cs[bj][0][e] = rs[t0 + e * st]; cs[bj][1][e] = rs[t0 + (4 + e) * st]; } }
            }
#pragma unroll
            for (int ai = 0; ai < 2; ++ai)
#pragma unroll
                for (int m = 0; m < 4; ++m) { const int row = row0 + ai * HALF + m * 16; bf16_t* rowp = O + (size_t)row * ldc + col0; const float rsc = (rsm == 1) ? rsl[row - u.pm * BM] * sc : sc;
                    f32x4 c0 = (f32x4){1.f, 1.f, 1.f, 1.f}, c1 = c0, s0 = (f32x4){0.f, 0.f, 0.f, 0.f}, s1 = s0;
                    if (dorope) { const float* tp = rope + (size_t)(row & 2047) * 16; c0 = *(const f32x4*)(tp); c1 = *(const f32x4*)(tp + 4); s0 = *(const f32x4*)(tp + 8); s1 = *(const f32x4*)(tp + 12);
                        if (fq == 0) { s0 = -s0; s1 = -s1; } }
#pragma unroll
                    for (int bj = 0; bj < 2; ++bj) { f32x4 v0 = acc[ai][bj][m][0], v1 = acc[ai][bj][m][1];
                        if (dorope) { f32x4 p0, p1;
#pragma unroll
                            for (int e = 0; e < 4; ++e) { p0[e] = __shfl_xor(v0[e], 16); p1[e] = __shfl_xor(v1[e], 16); }
                            if (fq < 2) { v0 = v0 * c0 + p0 * s0; v1 = v1 * c1 + p1 * s1; } }
                        v0 = v0 * rsc * cs[bj][0]; v1 = v1 * rsc * cs[bj][1];
                        if (mode == 3 || (mode == 4 && u.pn < 4)) {
                            const int c0 = col0 + bj * HALF; size_t off;
                            if (mode == 3) { const int bb = row >> 11, tt = row & 2047, r = tt & ((1 << gsh) - 1), uu = tt >> gsh, tile = bb * 64 + (r << (6 - gsh)) + (uu >> 5);
                                const int sec = c0 >> 10, hc = c0 & 1023, hh = hc >> 6, dc = (hc >> 3) & 7;
                                off = (size_t)sec * ((size_t)16384 * 1024) + ((size_t)((tile * 16 + hh) * 4 + (dc >> 1)) * 512) + ((uu & 31) + 32 * (dc & 1)) * 8; }
                            else { const int tile = row >> 5, sec = c0 >> 9, hc = c0 & 511, hh = hc >> 7, dc = (hc >> 3) & 15;
                                off = (size_t)sec * ((size_t)16384 * 512) + ((size_t)((tile * 4 + hh) * 8 + (dc >> 1)) * 512) + ((row & 31) + 32 * (dc & 1)) * 8; }
                            store8(rsrc, O + off, v0, v1);
                        } else if (mode == 4) { store8(rsrc, O2 + (size_t)row * 1024 + (col0 + bj * HALF - 1024), v0, v1);
                        } else if (rsm == 2) {
                            const int p0 = col0 + bj * HALF; store8(rsrc, O + ((size_t)(row >> 5) * (size_t)(ldc >> 4) + (p0 >> 4)) * 512 + ((row & 31) + 32 * ((p0 >> 3) & 1)) * 8, v0, v1);
                        } else store8(rsrc, rowp + bj * HALF, v0, v1); } }
        }
    }
};

template <class Epi, class Sched>
__device__ __forceinline__ void gemm_phase(PG8_LAS unsigned char* lds, const Gemm g, const Sched& S, const Epi& E) {
    int tid = threadIdx.x; asm volatile("" : "+v"(tid));
    const int wid = __builtin_amdgcn_readfirstlane(tid >> 6), lane = tid & 63, wr = wid >> 2, wc = wid & 3, fr = lane & 15, fq = lane >> 4;
    const int K = g.K, nt = K / BK;
    unsigned voffA[2], voffB[2];
#pragma unroll
    for (int i = 0; i < 2; ++i) { int R, C; stage_rc(tid * 16 + i * 8192, R, C); const int Rb = Epi::PERM ? ((R & ~31) + perm32(R & 31)) : R;
        voffA[i] = (unsigned)(R * g.lda + C) * 2u; voffB[i] = (unsigned)(Rb * g.bdil * g.ldb + C) * 2u; }
    const unsigned kstep = (unsigned)(BK * 2);
    const unsigned hstepA = (unsigned)HALF * (unsigned)g.lda * 2u;
    const unsigned tstepA = 2u * hstepA;
    const char* const baseA = (const char*)g.A; const char* const baseB = (const char*)g.Bt;
    const unsigned ldsw = (unsigned)wid * 1024u;
    const int aoff = lds_byte(wr * 64 + fr, fq * 8), boff = lds_byte(wc * 32 + fr, fq * 8);
#define PG8_SA(b, h) (((b) * 2 + (h)) * HTB)
#define PG8_SB(b, h) ((4 + (b) * 2 + (h)) * HTB)
#define PG8_STAGE(bufoff, gbase, uoff, voff) do { _Pragma("unroll") for (int _i = 0; _i < 2; ++_i) \
        __builtin_amdgcn_global_load_lds((const unsigned*)((gbase) + (size_t)((unsigned)(uoff) + (voff)[_i])), (PG8_LAS unsigned*)(lds + (bufoff) + ldsw + _i * 8192), 16, 0, 0); } while (0)
#define PG8_LDA(dst, b, h) do { _Pragma("unroll") for (int m = 0; m < 4; ++m) _Pragma("unroll") for (int k = 0; k < 2; ++k) dst[m][k] = *(const PG8_LAS bf16x8*)(lds + PG8_SA(b, h) + aoff + m * 2048 + k * 1024); } while (0)
#define PG8_LDB(dst, b, h) do { _Pragma("unroll") for (int n = 0; n < 2; ++n) _Pragma("unroll") for (int k = 0; k < 2; ++k) dst[n][k] = *(const PG8_LAS bf16x8*)(lds + PG8_SB(b, h) + boff + n * 2048 + k * 1024); } while (0)
#define PG8_MMA(ai, bj, At, Bt) do { __builtin_amdgcn_s_setprio(1); _Pragma("unroll") for (int m = 0; m < 4; ++m) _Pragma("unroll") for (int n = 0; n < 2; ++n) _Pragma("unroll") for (int k = 0; k < 2; ++k) \
        acc[ai][bj][m][n] = __builtin_amdgcn_mfma_f32_16x16x32_bf16(Bt[n][k], At[m][k], acc[ai][bj][m][n], 0, 0, 0); __builtin_amdgcn_s_setprio(0); } while (0)
#ifndef PROBE_XMFMA
#define PROBE_XMFMA 0
#endif
#define PG8_XMMA() do { const bf16x8 z_ = (bf16x8){0, 0, 0, 0, 0, 0, 0, 0}; _Pragma("unroll") for (int x_ = 0; x_ < PROBE_XMFMA; ++x_) acc[1][1][x_ & 3][(x_ >> 2) & 1] = __builtin_amdgcn_mfma_f32_16x16x32_bf16(z_, At[x_ & 3][0], acc[1][1][x_ & 3][(x_ >> 2) & 1], 0, 0, 0); } while (0)
#ifndef PG8_ALIGN_EPI
#define PG8_ALIGN_EPI 1
#endif
#define PG8_WAIT_V(n) asm volatile("s_waitcnt vmcnt(" #n ")" ::: "memory")
#define PG8_WAIT_L(n) asm volatile("s_waitcnt lgkmcnt(" #n ")" ::: "memory")
#define PG8_BAR __builtin_amdgcn_s_barrier()
#define PG8_SCHED __builtin_amdgcn_sched_barrier(0)
    Unit cur, nxt; int ui = 0;
    if (!S.next(0, cur)) return;
    f32x4 acc[2][2][4][2];
#pragma unroll
    for (int a = 0; a < 2; ++a)
#pragma unroll
        for (int b = 0; b < 2; ++b)
#pragma unroll
            for (int m = 0; m < 4; ++m)
#pragma unroll
                for (int n = 0; n < 2; ++n) acc[a][b][m][n] = (f32x4){0.f, 0.f, 0.f, 0.f};
    bf16x8 At[4][2], B0[2][2], B1[2][2];
    unsigned cA = (unsigned)cur.pm * tstepA, cB0 = b_half_off(g, cur.pn, 0), cB1 = b_half_off(g, cur.pn, 1);
#define PG8_RSL(par) ((PG8_LAS float*)(lds + STAGE_BYTES + 2048 + (par) * 1024))
#define PG8_STAGE_RS(un, par) do { if (E.rsm == 1 && wid < 4) __builtin_amdgcn_global_load_lds((const unsigned*)(E.rs + (size_t)(un).pm * BM + wid * 64 + lane), (PG8_LAS unsigned*)(PG8_RSL(par) + wid * 64), 4, 0, 0); } while (0)
    PG8_STAGE_RS(cur, 0);
    PG8_STAGE(PG8_SB(0, 0), baseB, cB0, voffB); PG8_STAGE(PG8_SB(0, 1), baseB, cB1, voffB); PG8_STAGE(PG8_SA(0, 0), baseA, cA, voffA); PG8_STAGE(PG8_SA(0, 1), baseA, cA + hstepA, voffA);
    if (wr == 1) PG8_BAR;
    PG8_WAIT_V(2); PG8_BAR;
    PG8_STAGE(PG8_SB(1, 0), baseB, cB0 + kstep, voffB); PG8_STAGE(PG8_SA(1, 0), baseA, cA + kstep, voffA); PG8_STAGE(PG8_SB(1, 1), baseB, cB1 + kstep, voffB);
    PG8_WAIT_V(6); PG8_BAR;
    for (;;) {
        const bool has_next = S.next(ui + 1, nxt);
        const unsigned nA = has_next ? (unsigned)nxt.pm * tstepA : cA;
        const unsigned nB0 = has_next ? b_half_off(g, nxt.pn, 0) : cB0, nB1 = has_next ? b_half_off(g, nxt.pn, 1) : cB1;
        for (int t = 0; t < nt; t += 2) {
            const bool last = (t == nt - 2);
            const unsigned a1 = cA + (unsigned)(t + 1) * kstep;
            const unsigned a2 = last ? nA : cA + (unsigned)(t + 2) * kstep;
            const unsigned b2_0 = last ? nB0 : cB0 + (unsigned)(t + 2) * kstep, b2_1 = last ? nB1 : cB1 + (unsigned)(t + 2) * kstep;
            const unsigned a3 = a2 + kstep, b3_0 = b2_0 + kstep, b3_1 = b2_1 + kstep;
            PG8_LDB(B0, 0, 0); PG8_LDB(B1, 0, 1); PG8_SCHED; PG8_LDA(At, 0, 0); PG8_STAGE(PG8_SA(1, 1), baseA, a1 + hstepA, voffA);
            PG8_WAIT_V(8); PG8_WAIT_L(0); PG8_BAR; PG8_MMA(0, 0, At, B0); PG8_MMA(0, 1, At, B1); PG8_BAR; PG8_SCHED;
            PG8_LDA(At, 0, 1); PG8_STAGE(PG8_SB(0, 0), baseB, b2_0, voffB); PG8_STAGE(PG8_SB(0, 1), baseB, b2_1, voffB); PG8_STAGE(PG8_SA(0, 0), baseA, a2, voffA);
            PG8_WAIT_V(8); PG8_WAIT_L(0); PG8_BAR; PG8_MMA(1, 0, At, B0); PG8_MMA(1, 1, At, B1); PG8_XMMA(); PG8_BAR; PG8_SCHED;
            PG8_LDB(B0, 1, 0); PG8_LDB(B1, 1, 1); PG8_SCHED; PG8_LDA(At, 1, 0); PG8_STAGE(PG8_SA(0, 1), baseA, a2 + hstepA, voffA);
            PG8_WAIT_V(8); PG8_WAIT_L(0); PG8_BAR; PG8_MMA(0, 0, At, B0); PG8_MMA(0, 1, At, B1); PG8_BAR; PG8_SCHED;
            PG8_LDA(At, 1, 1); PG8_STAGE(PG8_SB(1, 0), baseB, b3_0, voffB); PG8_STAGE(PG8_SB(1, 1), baseB, b3_1, voffB); PG8_STAGE(PG8_SA(1, 0), baseA, a3, voffA);
            PG8_WAIT_V(8); PG8_WAIT_L(0); PG8_BAR; PG8_MMA(1, 0, At, B0); PG8_MMA(1, 1, At, B1); PG8_XMMA(); PG8_BAR; PG8_SCHED;
        }
        if (PG8_ALIGN_EPI) { if (wr == 0) PG8_BAR; }
        E(acc, cur, wr, wc, fr, fq, PG8_RSL(ui & 1));
        if (!has_next) break;
#pragma unroll
        for (int a = 0; a < 2; ++a)
#pragma unroll
            for (int b = 0; b < 2; ++b)
#pragma unroll
                for (int m = 0; m < 4; ++m)
#pragma unroll
                    for (int n = 0; n < 2; ++n) acc[a][b][m][n] = (f32x4){0.f, 0.f, 0.f, 0.f};
        cur = nxt; cA = nA; cB0 = nB0; cB1 = nB1; ++ui;
        PG8_STAGE_RS(cur, ui & 1);
        if (PG8_ALIGN_EPI) { if (wr == 1) PG8_BAR; }
    }
    PG8_WAIT_V(0);
    if (!PG8_ALIGN_EPI) { if (wr == 0) PG8_BAR; }
    PG8_BAR;
#undef PG8_RSL
#undef PG8_STAGE_RS
#undef PG8_SA
#undef PG8_SB
#undef PG8_STAGE
#undef PG8_LDA
#undef PG8_LDB
#undef PG8_MMA
#undef PG8_XMMA
#undef PG8_WAIT_V
#undef PG8_WAIT_L
#undef PG8_BAR
#undef PG8_SCHED
}
}
#define GAS __attribute__((address_space(1)))
#define LAS __attribute__((address_space(3)))
typedef unsigned short bf16;
typedef unsigned v4u __attribute__((ext_vector_type(4)));
typedef float f32x4 __attribute__((ext_vector_type(4)));
typedef short bf16x8 __attribute__((ext_vector_type(8)));
typedef GAS unsigned gu32;
typedef GAS unsigned long long gu64;
#define RLX_AGENT __ATOMIC_RELAXED, __HIP_MEMORY_SCOPE_AGENT
#define LDS_WAIT() asm volatile("s_waitcnt lgkmcnt(0)" ::: "memory")
#define VM_WAIT() asm volatile("s_waitcnt vmcnt(0)" ::: "memory")
__device__ __forceinline__ unsigned long long rt() { return __builtin_amdgcn_s_memrealtime(); }
__device__ __forceinline__ unsigned f2bf(float f) { unsigned u = __builtin_bit_cast(unsigned, f); return (u + 0x7fffu + ((u >> 16) & 1u)) >> 16; }
__device__ __forceinline__ unsigned pk2(float lo, float hi) { return f2bf(lo) | (f2bf(hi) << 16); }

#define XB_TMO      128
#define XB_XCNT(j)  (256  + 64 * (j))
#define XB_XSUB(j)  (1280 + 64 * (j))
#define XB_XGEN(j)  (2304 + 64 * (j))
#define XB_TOP      3328
#define XB_TOPGEN   3392
#define XCD_BAR_WORDS 3456
#define XB_SPIN_CAP (1u << 18)

__device__ __forceinline__ unsigned xb_ld(unsigned* p)              { return __hip_atomic_load(p, __ATOMIC_RELAXED, __HIP_MEMORY_SCOPE_AGENT); }
__device__ __forceinline__ unsigned xb_add(unsigned* p, unsigned v) { return __hip_atomic_fetch_add(p, v, __ATOMIC_RELAXED, __HIP_MEMORY_SCOPE_AGENT); }
__device__ __forceinline__ unsigned xb_xcc_id() { return (unsigned)__builtin_amdgcn_s_getreg((3 << 11) | 20) & 0xFu; }
#define XB_SPIN(cond, bar) do { unsigned _sp = 0; while (cond) { __builtin_amdgcn_s_sleep(1); \
    if ((++_sp & 255u) == 0u) { if (xb_ld(&(bar)[XB_TMO])) break; if (_sp > XB_SPIN_CAP) { atomicAdd(&(bar)[XB_TMO], 1u); break; } } } } while (0)

struct XcdBarrier {
    unsigned* bar; unsigned x;
    volatile LAS unsigned* st;
};

__device__ __forceinline__ XcdBarrier xcd_barrier_post(unsigned* bar, volatile LAS unsigned* st) {
    XcdBarrier b; b.bar = bar; b.x = xb_xcc_id(); b.st = st;
    if (threadIdx.x == 0) (void)xb_add(&bar[XB_XCNT(b.x)], 1u);
    return b;
}
__device__ __forceinline__ void xcd_barrier_complete(unsigned* bar, unsigned x, unsigned& nloc, unsigned& nx) {
    const unsigned G = gridDim.x * gridDim.y * gridDim.z;
    unsigned sum, cnt, mine, sp = 0u;
    for (;;) {
        sum = 0u; cnt = 0u; mine = 0u;
#pragma unroll
        for (unsigned j = 0; j < 16; ++j) { const unsigned c = xb_ld(&bar[XB_XCNT(j)]); sum += c; cnt += (c > 0u) ? 1u : 0u; mine = (j == x) ? c : mine; }
        if (sum == G) break;
        __builtin_amdgcn_s_sleep(1);
        if ((++sp & 255u) == 0u) { if (xb_ld(&bar[XB_TMO])) break; if (sp > XB_SPIN_CAP) { atomicAdd(&bar[XB_TMO], 1u); break; } }
    }
    nloc = mine > 0u ? mine : 1u; nx = cnt > 0u ? cnt : 1u;
}

__device__ __forceinline__ void xcd_barrier(const XcdBarrier& b) {
    asm volatile("s_waitcnt vmcnt(0)" ::: "memory");
    __syncthreads();
    if (threadIdx.x == 0) {
        unsigned* bar = b.bar;
        __builtin_amdgcn_s_waitcnt(0);
        unsigned nloc = b.st[0], nx = b.st[1];
        if (nloc == 0u) { xcd_barrier_complete(bar, b.x, nloc, nx); b.st[0] = nloc; b.st[1] = nx; }
        const unsigned old = xb_add(&bar[XB_XSUB(b.x)], 1u);
        const unsigned gen = old / nloc;
        if (old + 1u == (gen + 1u) * nloc) {
            __builtin_amdgcn_fence(__ATOMIC_RELEASE, "agent");
            asm volatile("s_waitcnt vmcnt(0)" ::: "memory");
            const unsigned og = xb_add(&bar[XB_TOP], 1u);
            const unsigned tg = og / nx;
            if (og + 1u == (tg + 1u) * nx) xb_add(&bar[XB_TOPGEN], 1u);
            else XB_SPIN(xb_ld(&bar[XB_TOPGEN]) == tg, bar);
            __builtin_amdgcn_fence(__ATOMIC_ACQUIRE, "agent");
            xb_add(&bar[XB_XGEN(b.x)], 1u);
            asm volatile("s_waitcnt vmcnt(0)" ::: "memory");
        } else {
            XB_SPIN(xb_ld(&bar[XB_XGEN(b.x)]) == gen, bar);
            __builtin_amdgcn_fence(__ATOMIC_ACQUIRE, "agent");
            asm volatile("s_waitcnt vmcnt(0)" ::: "memory");
        }
    }
    __syncthreads();
}

constexpr int NWAVES = 8;
constexpr int BATCH = 8, SEQ = 2048, D = 1024, FF = 2816, DEPTH = 4;
constexpr int M = BATCH * SEQ;
constexpr float EPS = 1e-6f;
constexpr int ML_PROJ = 3080;
constexpr float ATT_QSCALE = 0.125f * 1.4426950408889634f;
constexpr int LDX = D + 64;
constexpr int LDQ = 2048 + 64;
constexpr int LDT = M + 64;
constexpr float ML_QSCALE = 0.08838834764831845f;

constexpr size_t MiB = 1u << 20;
constexpr size_t WS_CTL = 0, CTL_ZERO_BYTES = 32768;
constexpr size_t WS_ROPE = 1 * MiB;
constexpr size_t WS_GATEW = WS_ROPE + 256 * 1024;
constexpr size_t WS_GATES = WS_ROPE + 512 * 1024;
constexpr size_t WS_LSE = 2 * MiB;
constexpr size_t WS_NST = 3 * MiB;
constexpr size_t WS_MST = 3 * MiB + 512 * 1024;
constexpr size_t WS_RS = 5 * MiB;
constexpr size_t WS_GV = 4 * MiB;
constexpr size_t WS_WUP = 8 * MiB;
constexpr size_t WS_WDN = 96 * MiB;
constexpr size_t WS_WCIN = 140 * MiB;
constexpr size_t WS_WCOUT = 152 * MiB;
constexpr size_t WS_WAIN = 156 * MiB;
constexpr size_t WS_WAOUT = 174 * MiB;
constexpr size_t WS_WMIN = 176 * MiB;
constexpr size_t WS_WMOUT = 183 * MiB;
constexpr size_t WS_XN = 186 * MiB;
constexpr size_t WS_BIG = 220 * MiB;
constexpr size_t WS_TR = WS_BIG + 66 * MiB;
constexpr size_t WS_Y = WS_BIG + 88 * MiB;
constexpr size_t WS_R2 = 340 * MiB;
constexpr size_t WS_END = 406 * MiB;
static_assert((size_t)M * LDX * 2 <= 34 * MiB && (size_t)M * LDQ * 2 <= 66 * MiB && (size_t)1536 * LDT * 2 <= 54 * MiB, "d_ws map");
constexpr int CW_BAR = 4096;

constexpr int RING_OFF = 0, RING_BYTES = 131072;
constexpr int LDS_BYTES = 147456;
constexpr int MISC_OFF = LDS_BYTES - 512;

struct Args { const float* in[17]; float* out; unsigned char* ws; int ph_lo, ph_hi; };

struct Frame {
    LAS unsigned char* lds;
    volatile LAS unsigned* MISC;
    gu32* ctl;
    int vcu, G;
    unsigned char* ws;
};
struct LaneId { int tid, lane, wave; };
__device__ __forceinline__ LaneId lane_id() { int t = threadIdx.x; asm volatile("" : "+v"(t)); LaneId L; L.tid = t; L.lane = t & 63; L.wave = __builtin_amdgcn_readfirstlane(t >> 6); return L; }

__device__ __forceinline__ float wave_sum(float v) {
#pragma unroll
    for (int o = 1; o < 64; o <<= 1) v += __shfl_xor(v, o);
    return v;
}
__device__ __forceinline__ float wave_max(float v) {
#pragma unroll
    for (int o = 1; o < 64; o <<= 1) v = fmaxf(v, __shfl_xor(v, o));
    return v;
}
__device__ __forceinline__ float wave_incl_sum(float v, int lane) {
#pragma unroll
    for (int o = 1; o < 64; o <<= 1) { const float t = __shfl_up(v, o); if (lane >= o) v += t; }
    return v;
}
__device__ __forceinline__ float wave_incl_max(float v, int lane) {
#pragma unroll
    for (int o = 1; o < 64; o <<= 1) { const float t = __shfl_up(v, o); if (lane >= o) v = fmaxf(v, t); }
    return v;
}
__device__ __forceinline__ float bflo(unsigned w) { return __uint_as_float(w << 16); }
__device__ __forceinline__ float bfhi(unsigned w) { return __uint_as_float(w & 0xffff0000u); }
__device__ __forceinline__ float bf2f(bf16 u) { return __uint_as_float((unsigned)u << 16); }
__device__ __forceinline__ float dot8(const v4u a, const v4u b, float acc) {
    acc += bflo(a.x) * bflo(b.x); acc += bfhi(a.x) * bfhi(b.x); acc += bflo(a.y) * bflo(b.y); acc += bfhi(a.y) * bfhi(b.y);
    acc += bflo(a.z) * bflo(b.z); acc += bfhi(a.z) * bfhi(b.z); acc += bflo(a.w) * bflo(b.w); acc += bfhi(a.w) * bfhi(b.w); return acc;
}
__device__ __forceinline__ float bfel(const v4u a, int i) { const unsigned w = a[i >> 1]; return (i & 1) ? bfhi(w) : bflo(w); }
__device__ __forceinline__ float ld_f32_coherent(const float* p) { return __uint_as_float(__hip_atomic_load((const unsigned*)p, RLX_AGENT)); }
__device__ __forceinline__ float logsigmoid_f(float x) { return fminf(x, 0.f) - log1pf(expf(-fabsf(x))); }

__device__ __forceinline__ void thin_phase(Frame& F, const float* xin, bf16* X, const bf16* y, const float* gpost, float pscale, float* rs, float* fout, const float* gatew, float* gates) {
    const LaneId li = lane_id(); const int gw = F.vcu * NWAVES + li.wave, NGW = F.G * NWAVES, lane = li.lane;
    const __amdgpu_buffer_rsrc_t xrsrc = __builtin_amdgcn_make_buffer_rsrc((void*)X, 0, 0x7fffffff, 0x00020000);
    f32x4 gp[4];
#pragma unroll
    for (int i = 0; i < 4; ++i) { const int col = 512 * (i >> 1) + 8 * lane + 4 * (i & 1); gp[i] = gpost ? *(const f32x4*)(gpost + col) : (f32x4){0.f, 0.f, 0.f, 0.f}; }
    for (int m0 = gw; m0 < M; m0 += 2 * NGW) {
        f32x4 xv[2][4]; f32x4 yf[2][4];
#pragma unroll
        for (int rr = 0; rr < 2; ++rr) { const int m = (m0 + rr * NGW < M) ? m0 + rr * NGW : m0;
            if (xin) {
#pragma unroll
                for (int i = 0; i < 4; ++i) xv[rr][i] = __builtin_nontemporal_load((const GAS f32x4*)(xin + (size_t)m * D + 512 * (i >> 1) + 8 * lane + 4 * (i & 1)));
            } else {
#pragma unroll
                for (int j = 0; j < 2; ++j) { const v4u w = *(const GAS v4u*)(X + (size_t)m * LDX + 512 * j + 8 * lane);
                    xv[rr][2 * j] = (f32x4){bflo(w.x), bfhi(w.x), bflo(w.y), bfhi(w.y)}; xv[rr][2 * j + 1] = (f32x4){bflo(w.z), bfhi(w.z), bflo(w.w), bfhi(w.w)}; }
            }
            if (y) {
#pragma unroll
                for (int j = 0; j < 2; ++j) { const v4u w = __builtin_nontemporal_load((const GAS v4u*)(y + (size_t)m * D + 512 * j + 8 * lane));
                    yf[rr][2 * j] = (f32x4){bflo(w.x), bfhi(w.x), bflo(w.y), bfhi(w.y)}; yf[rr][2 * j + 1] = (f32x4){bflo(w.z), bfhi(w.z), bflo(w.w), bfhi(w.w)}; }
            }
        }
        if (y) {
            float ssq[2];
#pragma unroll
            for (int rr = 0; rr < 2; ++rr) { ssq[rr] = 0.f;
#pragma unroll
                for (int i = 0; i < 4; ++i) ssq[rr] += (yf[rr][i].x * yf[rr][i].x + yf[rr][i].y * yf[rr][i].y) + (yf[rr][i].z * yf[rr][i].z + yf[rr][i].w * yf[rr][i].w); }
#pragma unroll
            for (int o = 1; o < 64; o <<= 1) { ssq[0] += __shfl_xor(ssq[0], o); ssq[1] += __shfl_xor(ssq[1], o); }
#pragma unroll
            for (int rr = 0; rr < 2; ++rr) { const float r1 = pscale / sqrtf(ssq[rr] * (1.f / D) + EPS);
#pragma unroll
                for (int i = 0; i < 4; ++i) xv[rr][i] = xv[rr][i] + yf[rr][i] * gp[i] * r1; }
        }
        if (fout) {
#pragma unroll
            for (int rr = 0; rr < 2; ++rr) { const int m = m0 + rr * NGW; if (m < M) {
#pragma unroll
                for (int i = 0; i < 4; ++i) *(GAS f32x4*)(fout + (size_t)m * D + 512 * (i >> 1) + 8 * lane + 4 * (i & 1)) = xv[rr][i]; } }
        } else {
            float ssq[2];
#pragma unroll
            for (int rr = 0; rr < 2; ++rr) { ssq[rr] = 0.f;
#pragma unroll
                for (int i = 0; i < 4; ++i) ssq[rr] += (xv[rr][i].x * xv[rr][i].x + xv[rr][i].y * xv[rr][i].y) + (xv[rr][i].z * xv[rr][i].z + xv[rr][i].w * xv[rr][i].w); }
#pragma unroll
            for (int o = 1; o < 64; o <<= 1) { ssq[0] += __shfl_xor(ssq[0], o); ssq[1] += __shfl_xor(ssq[1], o); }
#pragma unroll
            for (int rr = 0; rr < 2; ++rr) { const int m = m0 + rr * NGW; if (m < M) {
                const float r2 = 1.f / sqrtf(ssq[rr] * (1.f / D) + EPS);
#pragma unroll
                for (int j = 0; j < 2; ++j) { v4u w; w.x = pk2(xv[rr][2 * j].x, xv[rr][2 * j].y); w.y = pk2(xv[rr][2 * j].z, xv[rr][2 * j].w); w.z = pk2(xv[rr][2 * j + 1].x, xv[rr][2 * j + 1].y); w.w = pk2(xv[rr][2 * j + 1].z, xv[rr][2 * j + 1].w);
                    __builtin_amdgcn_raw_buffer_store_b128(w, xrsrc, (int)(((size_t)m * LDX + 512 * j + 8 * lane) * 2), 0, 16); }
                if (lane == 0) rs[m] = r2;
                if (gatew) {
                    float mine = 0.f;
#pragma unroll
                    for (int jg = 0; jg < 8; ++jg) { float s = 0.f;
#pragma unroll
                        for (int i = 0; i < 4; ++i) { const f32x4 wv = *(const GAS f32x4*)(gatew + jg * D + 512 * (i >> 1) + 8 * lane + 4 * (i & 1)); s += (xv[rr][i].x * wv.x + xv[rr][i].y * wv.y) + (xv[rr][i].z * wv.z + xv[rr][i].w * wv.w); }
                        s = wave_sum(s); if (lane == jg) mine = s * r2; }
                    if (lane < 8) gates[(size_t)m * 8 + lane] = mine;
                }
            } }
        }
    }
}

__device__ __forceinline__ void conv_phase(Frame& F, bf16* Bz, const bf16* CU, const float* ck) {
    const LaneId li = lane_id(); const int gw = F.vcu * NWAVES + li.wave, NGW = F.G * NWAVES, lane = li.lane;
    f32x4 kk[3][4];
#pragma unroll
    for (int l = 0; l < 3; ++l)
#pragma unroll
        for (int i = 0; i < 4; ++i) kk[l][i] = *(const f32x4*)(ck + l * D + 512 * (i >> 1) + 8 * lane + 4 * (i & 1));
    const int per = (M + NGW - 1) / NGW;
    const int m_lo = gw * per, m_hi = (m_lo + per < M) ? m_lo + per : M;
    v4u c1[2], c2[2];
#pragma unroll
    for (int j = 0; j < 2; ++j) { c1[j] = (v4u){0u, 0u, 0u, 0u}; c2[j] = c1[j]; }
    if (m_lo < M) { const int t0 = m_lo & (SEQ - 1);
#pragma unroll
        for (int j = 0; j < 2; ++j) { const size_t off = (size_t)m_lo * D + 512 * j + 8 * lane;
            if (t0 >= 1) c1[j] = *(const GAS v4u*)(CU + off - D);
            if (t0 >= 2) c2[j] = *(const GAS v4u*)(CU + off - 2 * D); } }
    for (int m = m_lo; m < m_hi; ++m) {
        if ((m & (SEQ - 1)) == 0) {
#pragma unroll
            for (int j = 0; j < 2; ++j) { c1[j] = (v4u){0u, 0u, 0u, 0u}; c2[j] = c1[j]; } }
#pragma unroll
        for (int j = 0; j < 2; ++j) {
            const size_t off = (size_t)m * D + 512 * j + 8 * lane;
            const v4u bw = *(const GAS v4u*)(Bz + off); const v4u c0 = *(const GAS v4u*)(CU + off);
            float z[8];
#pragma unroll
            for (int e = 0; e < 8; ++e) { const f32x4 k0 = kk[0][2 * j + (e >> 2)], k1 = kk[1][2 * j + (e >> 2)], k2 = kk[2][2 * j + (e >> 2)];
                z[e] = bfel(bw, e) * (k0[e & 3] * bfel(c0, e) + k1[e & 3] * bfel(c1[j], e) + k2[e & 3] * bfel(c2[j], e)); }
            v4u w; w.x = pk2(z[0], z[1]); w.y = pk2(z[2], z[3]); w.z = pk2(z[4], z[5]); w.w = pk2(z[6], z[7]);
            *(GAS v4u*)(Bz + off) = w;
            c2[j] = c1[j]; c1[j] = c0;
        }
    }
}

__device__ __forceinline__ void transpose_tile(const float* src, int ld, int k0, int n0, bf16* dst, int Kd, LAS float* scr, int lane, const float* gk) {
    f32x4 v[16]; float gv[16];
#pragma unroll
    for (int i = 0; i < 16; ++i) { const int kk = 4 * i + (lane >> 4), c4 = (lane & 15) * 4;
        v[i] = __builtin_nontemporal_load((const f32x4*)(src + (size_t)(k0 + kk) * ld + n0 + c4)); gv[i] = gk ? gk[k0 + kk] : 1.0f; }
#pragma unroll
    for (int i = 0; i < 16; ++i) { const int kk = 4 * i + (lane >> 4), c4 = (lane & 15) * 4; const f32x4 w = v[i] * gv[i];
        scr[kk * 65 + c4 + 0] = w.x; scr[kk * 65 + c4 + 1] = w.y; scr[kk * 65 + c4 + 2] = w.z; scr[kk * 65 + c4 + 3] = w.w; }
    LDS_WAIT(); asm volatile("" ::: "memory");
    const int c = lane & 7;
#pragma unroll
    for (int j = 0; j < 8; ++j) { const int n = (lane >> 3) + 8 * j; const LAS float* s = scr + (8 * c) * 65 + n;
        v4u o; o.x = pk2(s[0 * 65], s[1 * 65]); o.y = pk2(s[2 * 65], s[3 * 65]); o.z = pk2(s[4 * 65], s[5 * 65]); o.w = pk2(s[6 * 65], s[7 * 65]);
        *(GAS v4u*)(dst + (size_t)n * Kd + k0 + 8 * c) = o; }
    LDS_WAIT(); asm volatile("" ::: "memory");
}

constexpr int CV_UP = 16 * 704, CV_DN = 8 * 704, CV_CIN = 2 * 768, CV_COUT = 2 * 256, CV_AIN = 2304, CV_AOUT = 256, CV_MIN = 896, CV_MOUT = 256;
constexpr int CV_O_DN = CV_UP, CV_O_CIN = CV_O_DN + CV_DN, CV_O_COUT = CV_O_CIN + CV_CIN, CV_O_ATT = CV_O_COUT + CV_COUT, CV_O_ML = CV_O_ATT + CV_AIN + CV_AOUT;
__device__ __forceinline__ void convert_range(Frame& F, const Args& a, int lo, int n, int wrank, int nw) {
    const LaneId li = lane_id();
    LAS float* scr = (LAS float*)(F.lds + li.wave * 16640);
    const int lane = li.lane;
    unsigned char* ws = F.ws;
    constexpr int N_UP = CV_UP, N_DN = CV_DN, N_CIN = CV_CIN, N_COUT = CV_COUT, N_AIN = CV_AIN, N_AOUT = CV_AOUT, N_MIN = CV_MIN;
    for (int it = lo + wrank; it < lo + n; it += nw) {
        int r = it; const float* src; int ld, K, kb, n0; bf16* dst; const float* gk = nullptr;
        if (r < N_UP) { const int mtx = r / 704; r -= mtx * 704; const int l = mtx >> 2, f = (mtx >> 1) & 1, which = mtx & 1;
            src = a.in[2 + 3 * f + which] + (size_t)l * D * FF; ld = FF; K = D; kb = r / 44; n0 = (r - kb * 44) * 64; gk = a.in[1] + (size_t)(l * 6 + 4 * f) * D;
            dst = (bf16*)(ws + WS_WUP) + (size_t)(l * 2 + f) * (2 * FF) * D + (size_t)(256 * (n0 >> 7) + (n0 & 127) + which * 128) * D; }
        else if ((r -= N_UP) < N_DN) { const int mtx = r / 704; r -= mtx * 704; const int l = mtx >> 1, f = mtx & 1;
            src = a.in[4 + 3 * f] + (size_t)l * FF * D; ld = D; K = FF; kb = r >> 4; n0 = (r & 15) * 64;
            dst = (bf16*)(ws + WS_WDN) + (size_t)(l * 2 + f) * D * FF + (size_t)n0 * FF; }
        else if ((r -= N_DN) < N_CIN) { const int j = r / 768; r -= j * 768;
            src = a.in[8] + (size_t)j * D * 3072; ld = 3072; K = D; kb = r / 48; n0 = (r - kb * 48) * 64; gk = a.in[1] + (size_t)((3 * j) * 6 + 2) * D;
            int drow = n0; if (n0 >= 2048) { const int f = n0 - 2048; drow = 1024 + 256 * (f >> 7) + 128 + (f & 127); } else if (n0 >= 1024) { const int f = n0 - 1024; drow = 1024 + 256 * (f >> 7) + (f & 127); }
            dst = (bf16*)(ws + WS_WCIN) + (size_t)j * 3072 * D + (size_t)drow * D; }
        else if ((r -= N_CIN) < N_COUT) { const int j = r >> 8; r &= 255;
            src = a.in[10] + (size_t)j * D * D; ld = D; K = D; kb = r >> 4; n0 = (r & 15) * 64;
            dst = (bf16*)(ws + WS_WCOUT) + (size_t)j * D * D + (size_t)n0 * D; }
        else if ((r -= N_COUT) < N_AIN) { src = a.in[11]; ld = 9216; K = D; kb = r / 144; n0 = (r - kb * 144) * 64; gk = a.in[1] + (size_t)(1 * 6 + 2) * D;
            dst = (bf16*)(ws + WS_WAIN) + (size_t)n0 * D; }
        else if ((r -= N_AIN) < N_AOUT) { src = a.in[12]; ld = D; K = D; kb = r >> 4; n0 = (r & 15) * 64;
            dst = (bf16*)(ws + WS_WAOUT) + (size_t)n0 * D; }
        else if ((r -= N_AOUT) < N_MIN) { src = a.in[13]; ld = ML_PROJ; K = D; kb = r / 56; const int gi = r - kb * 56; int drow; gk = a.in[1] + (size_t)(2 * 6 + 2) * D;
            if (gi < 16) { n0 = gi * 64; drow = n0; }
            else if (gi < 32) { n0 = 2048 + (gi - 16) * 64; drow = 1024 + (gi - 16) * 64; }
            else if (gi < 40) { n0 = 512 + (gi - 32) * 64; drow = 2048 + (gi - 32) * 64; }
            else { n0 = 1024 + (gi - 40) * 64; drow = 2560 + (gi - 40) * 64; }
            dst = (bf16*)(ws + WS_WMIN) + (size_t)drow * D; }
        else { r -= N_MIN; src = a.in[16]; ld = D; K = D; kb = r >> 4; n0 = (r & 15) * 64;
            dst = (bf16*)(ws + WS_WMOUT) + (size_t)n0 * D; }
        transpose_tile(src, ld, kb * 64, n0, dst, K, scr, lane, gk);
    }
}
__device__ __forceinline__ void convert_ffn(Frame& F, const Args& a, int l, int f, int wrank, int nw) {
    convert_range(F, a, (l * 4 + f * 2) * 704, 1408, wrank, nw); convert_range(F, a, CV_O_DN + (l * 2 + f) * 704, 704, wrank, nw);
}

__device__ __forceinline__ void prologue(Frame& F, const Args& a) {
    const LaneId li = lane_id();
    const int gw = F.vcu * NWAVES + li.wave, NGW = F.G * NWAVES, lane = li.lane;
    unsigned char* ws = F.ws;
    convert_range(F, a, 0, CV_O_ML + CV_MIN + CV_MOUT, gw, NGW);
    { const int gt = gw * 64 + lane;
      if (gt < SEQ * 8) { const int t = gt >> 3, i = gt & 7; const float inv = (float)exp(-((double)i / 8.0) * log(500000.0)); const float ang = (float)t * inv;
          float* tab = (float*)(ws + WS_ROPE); tab[t * 16 + i] = (float)cos((double)ang); tab[t * 16 + 8 + i] = (float)sin((double)ang); }
      if (gt < 8 * D) { const int j = gt >> 10, k = gt & 1023; ((float*)(ws + WS_GATEW))[gt] = a.in[13][(size_t)k * ML_PROJ + 3072 + j] * a.in[1][(size_t)(2 * 6 + 2) * D + k]; } }
    thin_phase(F, a.in[0], (bf16*)(ws + WS_XN), nullptr, nullptr, 0.f, (float*)(ws + WS_RS), nullptr, nullptr, nullptr);
}


typedef float f32x16 __attribute__((ext_vector_type(16)));
#define MFMA32(a, b, c) __builtin_amdgcn_mfma_f32_32x32x16_bf16((a), (b), (c), 0, 0, 0)
__device__ __forceinline__ bf16x8 as_frag(const v4u v) { return __builtin_bit_cast(bf16x8, v); }
__device__ __forceinline__ int pi32(int rho) { return (rho & ~12) | ((rho & 8) >> 1) | ((rho & 4) << 1); }
__device__ __forceinline__ v4u pack8(const float (&x)[8]) { v4u w; w.x = pg8::cvt_pk_bf16(x[0], x[1]); w.y = pg8::cvt_pk_bf16(x[2], x[3]); w.z = pg8::cvt_pk_bf16(x[4], x[5]); w.w = pg8::cvt_pk_bf16(x[6], x[7]); return w; }

__device__ __forceinline__ size_t ftr_off(int ftile, int p16, int slot) { return ((size_t)ftile * (M / 16) + p16) * 512 + slot * 8; }

__device__ __forceinline__ void attn_mfma(Frame& F, int g) {
    const int sh = 2 * g, L = SEQ >> sh, lt = 6 - sh;
    const bf16* QK = (const bf16*)(F.ws + WS_BIG); const bf16* VT = (const bf16*)(F.ws + WS_TR);
    bf16* OACC = (bf16*)(F.ws + WS_R2); float* LSE = (float*)(F.ws + WS_LSE);
    const LaneId li = lane_id(); const int lane = li.lane, r32 = lane & 31, hi = lane >> 5, pr = pi32(r32);
    const int gw = F.vcu * NWAVES + li.wave, NGW = F.G * NWAVES;
    for (int unit = gw; unit < BATCH * 16 * 64; unit += NGW) {
        const int bh = unit >> 6, t64 = unit & 63, b = bh >> 4, h = bh & 15;
        const int r = t64 >> lt, T = t64 & ((1 << lt) - 1);
        const size_t qrow = (size_t)(b << 11) + (size_t)(((32 * T + r32) << sh) + r);
        bf16x8 qf[4];
        { const GAS v4u* qp = (const GAS v4u*)(QK + (size_t)(((b * 64 + t64) * 16 + h) * 4) * 512 + (r32 + 32 * hi) * 8);
#pragma unroll
          for (int d0 = 0; d0 < 4; ++d0) qf[d0] = as_frag(qp[64 * d0]); }
        v4u kf[5][4];
#pragma unroll
        for (int j = 0; j < 5; ++j) { const int Tc = (T - 4 + j) < 0 ? 0 : (T - 4 + j);
            const GAS v4u* kp = (const GAS v4u*)(QK + (size_t)M * 1024 + (size_t)(((b * 64 + (r << lt) + Tc) * 16 + h) * 4) * 512 + (pr + 32 * hi) * 8);
#pragma unroll
            for (int d0 = 0; d0 < 4; ++d0) kf[j][d0] = kp[64 * d0]; }
        float lp = 0.f; if (g > 0) lp = LSE[qrow * 16 + h];
        f32x16 sc[5];
#pragma unroll
        for (int j = 0; j < 5; ++j) { f32x16 a;
#pragma unroll
            for (int i = 0; i < 16; ++i) a[i] = 0.f;
#pragma unroll
            for (int d0 = 0; d0 < 4; ++d0) a = MFMA32(as_frag(kf[j][d0]), qf[d0], a);
            sc[j] = a; }
        v4u vf[5][2][2];
#pragma unroll
        for (int j = 0; j < 5; ++j) { const int Tc = (T - 4 + j) < 0 ? 0 : (T - 4 + j);
#pragma unroll
            for (int db = 0; db < 2; ++db) { const int p16 = ((b << 11) + r * L + 32 * Tc) >> 4;
#pragma unroll
                for (int s = 0; s < 2; ++s) vf[j][db][s] = *(const GAS v4u*)(VT + ftr_off(2 * h + db, p16 + s, pr + 32 * hi)); } }
#pragma unroll
        for (int j = 0; j < 4; ++j) if ((T - 4 + j) < 0) {
#pragma unroll
            for (int i = 0; i < 16; ++i) sc[j][i] = -INFINITY; }
#pragma unroll
        for (int i = 0; i < 16; ++i) { const int kl = 16 * (i >> 3) + 8 * hi + (i & 7);
            sc[0][i] = (kl >= r32) ? sc[0][i] : -INFINITY; sc[4][i] = (kl <= r32) ? sc[4][i] : -INFINITY; }
        float mx = -INFINITY;
#pragma unroll
        for (int j = 0; j < 5; ++j)
#pragma unroll
            for (int i = 0; i < 16; i += 2) mx = fmaxf(fmaxf(mx, sc[j][i]), sc[j][i + 1]);
        mx = fmaxf(mx, __shfl_xor(mx, 32));
        float ls = 0.f; v4u pf[5][2];
#pragma unroll
        for (int j = 0; j < 5; ++j)
#pragma unroll
            for (int s = 0; s < 2; ++s) { float p[8];
#pragma unroll
                for (int e = 0; e < 8; ++e) { p[e] = __builtin_amdgcn_exp2f(sc[j][8 * s + e] - mx); ls += p[e]; }
                pf[j][s] = pack8(p); }
        ls += __shfl_xor(ls, 32);
        f32x16 o[2];
#pragma unroll
        for (int db = 0; db < 2; ++db)
#pragma unroll
            for (int i = 0; i < 16; ++i) o[db][i] = 0.f;
#pragma unroll
        for (int j = 0; j < 5; ++j)
#pragma unroll
            for (int db = 0; db < 2; ++db)
#pragma unroll
                for (int s = 0; s < 2; ++s) o[db] = MFMA32(as_frag(vf[j][db][s]), as_frag(pf[j][s]), o[db]);
        float inv = 1.f / ls, lse = mx + log2f(ls), wprev = 0.f;
        if (g > 0) { const float mm = fmaxf(lp, lse), e1 = exp2f(lp - mm), e2 = exp2f(lse - mm), den = e1 + e2;
            wprev = e1 / den; inv *= e2 / den; lse = mm + log2f(den); }
#pragma unroll
        for (int db = 0; db < 2; ++db)
#pragma unroll
            for (int s = 0; s < 2; ++s) { GAS v4u* op = (GAS v4u*)(OACC + qrow * LDX + h * 64 + 32 * db + 16 * s + 8 * hi); float x[8];
#pragma unroll
                for (int e = 0; e < 8; ++e) x[e] = o[db][8 * s + e] * inv;
                if (g > 0) { const v4u pv = *op;
#pragma unroll
                    for (int e = 0; e < 8; ++e) x[e] += wprev * bfel(pv, e); }
                *op = pack8(x); }
        if (hi == 0) LSE[qrow * 16 + h] = lse;
    }
}


__device__ __forceinline__ void mlstm_gate_prepass(Frame& F, const float* b_i, const float* b_f) {
    const float* GATES = (const float*)(F.ws + WS_GATES); float* GV = (float*)(F.ws + WS_GV);
    const LaneId li = lane_id(); const int lane = li.lane, gw = F.vcu * NWAVES + li.wave, NGW = F.G * NWAVES;
    for (int item = gw; item < 1024; item += NGW) {
        const int bh = item >> 5, c = item & 31, b = bh >> 2, h = bh & 3; const int tok = (b << 11) + c * 64 + lane;
        const float ig = GATES[(size_t)tok * 8 + h] + b_i[h]; const float lf = logsigmoid_f(GATES[(size_t)tok * 8 + 4 + h] + b_f[h]);
        const float bc = wave_incl_sum(lf, lane); const float u = ig - bc; const float run = wave_incl_max(u, lane);
        GV[(size_t)item * 192 + lane] = bc; GV[(size_t)item * 192 + 64 + lane] = u; GV[(size_t)item * 192 + 128 + lane] = run;
    }
}

__device__ __forceinline__ void mlstm_S_mfma(Frame& F) {
    const bf16* KVT = (const bf16*)(F.ws + WS_TR);
    bf16* CST = (bf16*)(F.ws + WS_R2); float* NST = (float*)(F.ws + WS_NST); float* MST = (float*)(F.ws + WS_MST); const float* GV = (const float*)(F.ws + WS_GV);
    const LaneId li = lane_id(); const int lane = li.lane, r32 = lane & 31, hi = lane >> 5, pr = pi32(r32), dvs = li.wave;
    LAS float* wsl = (LAS float*)(F.lds + li.wave * 512);
    for (int item = F.vcu; item < 128; item += F.G) {
        const int bh = item >> 2, dqt = item & 3, b = bh >> 2, h = bh & 3;
        f32x16 acc;
#pragma unroll
        for (int i = 0; i < 16; ++i) acc[i] = 0.f;
        float nacc = 0.f;
        const float bt_l = GV[(size_t)(bh * 32 + r32) * 192 + 63], am_l = GV[(size_t)(bh * 32 + r32) * 192 + 128 + 63];
        float marr = 0.f;
        { float m = 0.f;
          for (int c = 0; c < 32; ++c) { if (r32 == c) marr = m; m = __shfl(bt_l, c) + fmaxf(m, __shfl(am_l, c)); } }
        const GAS bf16* kTrow = (const GAS bf16*)KVT + ftr_off(4 * h + dqt, (b << 11) >> 4, pr + 32 * hi);
        const GAS bf16* vTrow = (const GAS bf16*)KVT + ftr_off(16 + 8 * h + dvs, (b << 11) >> 4, r32 + 32 * hi);
        v4u kfn[4], vrn[4]; float un;
#pragma unroll
        for (int ks = 0; ks < 4; ++ks) { kfn[ks] = *(const GAS v4u*)(kTrow + 512 * ks); vrn[ks] = *(const GAS v4u*)(vTrow + 512 * ks); }
        un = GV[(size_t)(bh * 32) * 192 + 64 + lane];
        for (int c = 0; c < 32; ++c) {
            const size_t sidx = (size_t)(bh * 32 + c);
            v4u kfc[4], vrc[4]; const float uc = un;
#pragma unroll
            for (int ks = 0; ks < 4; ++ks) { kfc[ks] = kfn[ks]; vrc[ks] = vrn[ks]; }
            { const int cn = c < 31 ? c + 1 : 31;
#pragma unroll
              for (int ks = 0; ks < 4; ++ks) { kfn[ks] = *(const GAS v4u*)(kTrow + (4 * cn + ks) * 512); vrn[ks] = *(const GAS v4u*)(vTrow + (4 * cn + ks) * 512); }
              un = GV[(size_t)(bh * 32 + cn) * 192 + 64 + lane]; }
#pragma unroll
            for (int s = 0; s < 2; ++s) { float x[8];
#pragma unroll
                for (int e = 0; e < 8; ++e) x[e] = acc[8 * s + e];
                *(GAS v4u*)(CST + (((sidx * 8 + dvs) * 4 + dqt) * 2 + s) * 512 + lane * 8) = pack8(x); }
            if (dvs == 0 && hi == 0) NST[sidx * 128 + 32 * dqt + pr] = nacc;
            const float m_prev = __shfl(marr, c), btot = __shfl(bt_l, c), m_new = btot + fmaxf(m_prev, __shfl(am_l, c));
            if (dvs == 0 && dqt == 0 && lane == 0) MST[sidx] = m_prev;
            const float we = expf(uc + btot - m_new); const float decay = expf(btot + m_prev - m_new);
            wsl[lane] = we;
            LDS_WAIT(); __builtin_amdgcn_wave_barrier();
#pragma unroll
            for (int i = 0; i < 16; ++i) acc[i] *= decay;
            float nsum = 0.f;
#pragma unroll
            for (int ks = 0; ks < 4; ++ks) {
                const v4u kf = kfc[ks]; const v4u vr = vrc[ks];
                const f32x4 w0 = *(const LAS f32x4*)(wsl + 16 * ks + 8 * hi), w1 = *(const LAS f32x4*)(wsl + 16 * ks + 8 * hi + 4);
                float x[8];
#pragma unroll
                for (int e = 0; e < 8; ++e) { const float w = (e < 4) ? w0[e & 3] : w1[e & 3]; x[e] = bfel(vr, e) * w; nsum += bfel(kf, e) * w; }
                acc = MFMA32(as_frag(kf), as_frag(pack8(x)), acc);
            }
            nsum += __shfl_xor(nsum, 32);
            nacc = decay * nacc + nsum;
            LDS_WAIT(); __builtin_amdgcn_wave_barrier();
        }
    }
}

__device__ __forceinline__ void mlstm_O_mfma(Frame& F) {
    const bf16* QKO = (const bf16*)(F.ws + WS_BIG); const bf16* KVT = (const bf16*)(F.ws + WS_TR);
    const bf16* CST = (const bf16*)(F.ws + WS_R2); const float* NST = (const float*)(F.ws + WS_NST); const float* MST = (const float*)(F.ws + WS_MST); const float* GV = (const float*)(F.ws + WS_GV);
    bf16* HOG = (bf16*)(F.ws + WS_BIG) + (size_t)M * 1024;
    const LaneId li = lane_id(); const int lane = li.lane, r32 = lane & 31, hi = lane >> 5, pr = pi32(r32), th = li.wave >> 2, dvq = li.wave & 3;
    LAS float* gl = (LAS float*)(F.lds + li.wave * 2048);
    constexpr float LOG2E = 1.4426950408889634f;
    for (int item = F.vcu; item < 1024; item += F.G) {
        const int bh = item >> 5, c = item & 31, b = bh >> 2, h = bh & 3; const int tok0 = (b << 11) + c * 64;
        const int t = 32 * th + r32;
        const float g_bc = GV[(size_t)item * 192 + lane], g_u = GV[(size_t)item * 192 + 64 + lane], g_run = GV[(size_t)item * 192 + 128 + lane];
        const float m_prev = ld_f32_coherent(MST + item);
        const float n_lo = NST[(size_t)item * 128 + lane], n_hi = NST[(size_t)item * 128 + 64 + lane];
        v4u cfr[2][8];
        { const GAS v4u* cp = (const GAS v4u*)(CST + (((size_t)item * 8 + 2 * dvq) * 8) * 512 + (pr + 32 * hi) * 8);
#pragma unroll
          for (int ks = 0; ks < 8; ++ks) cfr[0][ks] = cp[64 * ks]; }
        bf16x8 qf[8];
        { const GAS v4u* qp = (const GAS v4u*)(QKO + (size_t)((((tok0 >> 5) + th) * 4 + h) * 8) * 512 + (r32 + 32 * hi) * 8);
#pragma unroll
          for (int ks = 0; ks < 8; ++ks) qf[ks] = as_frag(qp[64 * ks]); }
        v4u kfr[2][8];
#pragma unroll
        for (int st = 0; st < 2; ++st) { const GAS v4u* kp = (const GAS v4u*)(QKO + (size_t)M * 512 + (size_t)((((tok0 >> 5) + st) * 4 + h) * 8) * 512 + (pr + 32 * hi) * 8);
#pragma unroll
            for (int ks = 0; ks < 8; ++ks) kfr[st][ks] = kp[64 * ks]; }
        { const float mt = g_bc + fmaxf(m_prev, g_run);
          gl[lane] = g_u * LOG2E; gl[64 + lane] = (g_bc - mt) * LOG2E; gl[128 + lane] = expf(g_bc + m_prev - mt); gl[192 + lane] = expf(-mt); gl[256 + lane] = n_lo; gl[320 + lane] = n_hi; }
        __builtin_amdgcn_wave_barrier();
        const float e2 = gl[64 + t], wit = gl[128 + t], emt = gl[192 + t];
        f32x16 sacc[2];
#pragma unroll
        for (int st = 0; st < 2; ++st) { f32x16 a;
#pragma unroll
            for (int i = 0; i < 16; ++i) a[i] = 0.f;
            if (st <= th) {
#pragma unroll
                for (int ks = 0; ks < 8; ++ks) a = MFMA32(as_frag(kfr[st][ks]), qf[ks], a);
            }
            sacc[st] = a; }
        { const GAS v4u* cp = (const GAS v4u*)(CST + (((size_t)item * 8 + 2 * dvq + 1) * 8) * 512 + (pr + 32 * hi) * 8);
#pragma unroll
          for (int ks = 0; ks < 8; ++ks) cfr[1][ks] = cp[64 * ks]; }
        v4u vfr[2][4];
#pragma unroll
        for (int dt = 0; dt < 2; ++dt) { const GAS v4u* vp = (const GAS v4u*)(KVT + ftr_off(16 + 8 * h + 2 * dvq + dt, tok0 >> 4, pr + 32 * hi));
#pragma unroll
            for (int j = 0; j < 4; ++j) vfr[dt][j] = vp[64 * j]; }
        v4u ogv[2][2];
#pragma unroll
        for (int dt = 0; dt < 2; ++dt)
#pragma unroll
            for (int s2 = 0; s2 < 2; ++s2) ogv[dt][s2] = *(const GAS v4u*)(HOG + (size_t)(tok0 + t) * 1024 + (size_t)h * 256 + 64 * dvq + 32 * dt + 16 * s2 + 8 * hi);
        float dsum = 0.f; v4u af[2][2];
#pragma unroll
        for (int st = 0; st < 2; ++st)
#pragma unroll
            for (int s2 = 0; s2 < 2; ++s2) { float x[8];
#pragma unroll
                for (int e = 0; e < 8; ++e) { const int sl = 16 * s2 + 8 * hi + e; const float w = __builtin_amdgcn_exp2f(e2 + gl[32 * st + sl]);
                    const bool ok = (st < th) || (st == th && sl <= r32); x[e] = ok ? sacc[st][8 * s2 + e] * w : 0.f; dsum += x[e]; }
                af[st][s2] = pack8(x); }
        dsum += __shfl_xor(dsum, 32);
        float nq = 0.f;
#pragma unroll
        for (int ks = 0; ks < 8; ++ks) { const f32x4 n0 = *(const LAS f32x4*)(gl + 256 + 16 * ks + 8 * hi), n1 = *(const LAS f32x4*)(gl + 256 + 16 * ks + 8 * hi + 4);
            const v4u qv = __builtin_bit_cast(v4u, qf[ks]);
            nq += n0.x * bflo(qv.x) + n0.y * bfhi(qv.x) + n0.z * bflo(qv.y) + n0.w * bfhi(qv.y) + n1.x * bflo(qv.z) + n1.y * bfhi(qv.z) + n1.z * bflo(qv.w) + n1.w * bfhi(qv.w); }
        nq += __shfl_xor(nq, 32);
        const float den = dsum + wit * nq; const float inv = 1.f / fmaxf(fabsf(den), emt);
        f32x16 hacc[2];
#pragma unroll
        for (int dt = 0; dt < 2; ++dt) { f32x16 a;
#pragma unroll
            for (int i = 0; i < 16; ++i) a[i] = 0.f;
#pragma unroll
            for (int ks = 0; ks < 8; ++ks) a = MFMA32(as_frag(cfr[dt][ks]), qf[ks], a);
#pragma unroll
            for (int i = 0; i < 16; ++i) a[i] *= wit;
#pragma unroll
            for (int st = 0; st < 2; ++st)
                if (st <= th) {
#pragma unroll
                    for (int s2 = 0; s2 < 2; ++s2) a = MFMA32(as_frag(vfr[dt][2 * st + s2]), as_frag(af[st][s2]), a);
                }
            hacc[dt] = a; }
#pragma unroll
        for (int dt = 0; dt < 2; ++dt)
#pragma unroll
            for (int s2 = 0; s2 < 2; ++s2) { float x[8];
#pragma unroll
                for (int e = 0; e < 8; ++e) x[e] = hacc[dt][8 * s2 + e] * inv * __builtin_amdgcn_rcpf(1.f + __builtin_amdgcn_exp2f(-LOG2E * bfel(ogv[dt][s2], e)));
                *(GAS v4u*)(HOG + (size_t)(tok0 + t) * 1024 + (size_t)h * 256 + 64 * dvq + 32 * dt + 16 * s2 + 8 * hi) = pack8(x); }
        __builtin_amdgcn_wave_barrier();
    }
}

#ifndef PROBE_PROLOGUE
#define PROBE_PROLOGUE 1
#endif
#ifndef PROBE_GEMM
#define PROBE_GEMM 1
#endif
#ifndef PROBE_THIN
#define PROBE_THIN 0
#endif
#ifndef PROBE_ATT0
#define PROBE_ATT0 0
#endif
#ifndef PROBE_MLS
#define PROBE_MLS 1
#endif
#ifndef PROBE_MLO
#define PROBE_MLO 1
#endif
#ifndef PROBE_UP
#define PROBE_UP 1
#endif
#ifndef PROBE_DOWN
#define PROBE_DOWN 1
#endif
#ifndef PROBE_BAR
#define PROBE_BAR 1
#endif
#ifndef MK_SPLIT
#define MK_SPLIT 0
#endif
constexpr int N_PHASE_IDS = 1 + 8 * 12;
__host__ __device__ inline bool phase_nonempty(int id) {
    if (id == 0) return true;
    const int s = (id - 1) >> 3, k = (id - 1) & 7, sub = s % 3, mix = (s / 3) % 3;
    if (k >= 6) return true;
    if (sub != 1) return k == 0;
    if (mix == 0) return k <= 1;
    if (mix == 1) return k <= 5;
    return k <= 2;
}

__global__ void __launch_bounds__(NWAVES * 64, 2) mk_fwd(Args args) {
    extern __shared__ __attribute__((aligned(16))) unsigned char lds[];
    Frame F;
    F.lds = (LAS unsigned char*)lds;
    F.MISC = (volatile LAS unsigned*)(F.lds + MISC_OFF);
    F.G = gridDim.x; { const int bx = blockIdx.x; F.vcu = (F.G % 8 == 0) ? (bx % 8) * (F.G / 8) + bx / 8 : bx; }
    F.ws = args.ws; F.ctl = (gu32*)(args.ws + WS_CTL);
    unsigned char* ws = args.ws;
    for (int u = threadIdx.x; u < (LDS_BYTES - MISC_OFF) / 4; u += NWAVES * 64) ((LAS unsigned*)(F.lds + MISC_OFF))[u] = 0u;
    __syncthreads();
#if MK_SPLIT
    const int lo = args.ph_lo, hi = args.ph_hi;
    int pid = 0;
#define RUN(k) ((pid = (k)), (lo <= pid && pid < hi))
#define SEAM() do { } while (0)
#else
    (void)xcd_barrier_post((unsigned*)(F.ctl + CW_BAR), F.MISC + 8);
    int pid = 0;
#define RUN(k) ((pid = (k)), true)
#define SEAM() do { if (pid + 1 < N_PHASE_IDS) { for (int pb_ = 0; pb_ < PROBE_BAR; ++pb_) { XcdBarrier bar_; bar_.bar = (unsigned*)(F.ctl + CW_BAR); bar_.x = xb_xcc_id(); bar_.st = F.MISC + 8; xcd_barrier(bar_); } } } while (0)
#endif

    bf16* const XN = (bf16*)(ws + WS_XN); bf16* const BIG = (bf16*)(ws + WS_BIG); bf16* const Y = (bf16*)(ws + WS_Y); bf16* const R2 = (bf16*)(ws + WS_R2);
    const float* const rope = (const float*)(ws + WS_ROPE);

    if (RUN(0)) { for (int pp_ = 0; pp_ < PROBE_PROLOGUE; ++pp_) prologue(F, args); SEAM(); }

    for (int s = 0; s < 12; ++s) {
        const int layer = s / 3, sub = s - 3 * layer, mix = layer % 3, mj = layer / 3, base = 1 + 8 * s;
        const bool is_ffn = (sub != 1);
        const int nrep = (!is_ffn && mix == 1) ? 3 : 1;
        for (int rep = 0; rep < nrep; ++rep) {
            if (RUN(base + 2 * rep)) {
                if (!is_ffn && mix == 2) mlstm_gate_prepass(F, args.in[14] + mj * 4, args.in[15] + mj * 4);
                {   pg8::Gemm g; pg8::EpiX E;
                    g.A = XN; g.M = M; g.K = D; g.lda = LDX; g.ldb = D; g.bdil = 1; E.O = BIG; E.O2 = nullptr; E.rope = rope; E.qscale = 1.f; E.rs = (const float*)(ws + WS_RS); E.rsm = 1; E.cdil = 1; E.gsh = 0;
                    if (is_ffn) { g.Bt = (const bf16*)(ws + WS_WUP) + (size_t)(layer * 2 + (sub >> 1)) * (2 * FF) * D; g.N = 2 * FF; E.mode = 1; E.ldc = FF; }
                    else if (mix == 0) { g.Bt = (const bf16*)(ws + WS_WCIN) + (size_t)mj * 3072 * D; g.N = 3072; E.mode = 2; E.ldc = 1024; E.O2 = BIG + (size_t)M * 1024; }
                    else if (mix == 1) { g.Bt = (const bf16*)(ws + WS_WAIN) + (size_t)(rep * 3072) * D; g.N = 2048; E.mode = 3; E.ldc = LDQ; E.qscale = ATT_QSCALE; E.gsh = 2 * rep; }
                    else { g.Bt = (const bf16*)(ws + WS_WMIN); g.N = 2048; E.mode = 4; E.ldc = LDQ; E.qscale = ML_QSCALE; E.O2 = BIG + (size_t)M * 1024; }
                    pg8::StaticOrder S; S.init(g.M, g.N, F.G, (int)blockIdx.x); for (int pg_ = 0; pg_ < (is_ffn ? PROBE_UP : 1) * PROBE_GEMM; ++pg_) pg8::gemm_phase<pg8::EpiX, pg8::StaticOrder>(F.lds + RING_OFF, g, S, E); }
                if (!is_ffn && mix != 0) {
                    pg8::Gemm g; pg8::EpiX E;
                    g.Bt = XN; g.N = M; g.K = D; g.lda = D; g.ldb = LDX; E.mode = 0; E.O = (bf16*)(ws + WS_TR); E.ldc = M; E.O2 = nullptr; E.rope = rope; E.qscale = 1.f; E.rs = (const float*)(ws + WS_RS); E.rsm = 2; E.cdil = 1; E.gsh = 0;
                    if (mix == 1) { g.A = (const bf16*)(ws + WS_WAIN) + (size_t)(rep * 3072 + 2048) * D; g.M = 1024; g.bdil = 1 << (2 * rep); E.cdil = g.bdil; }
                    else { g.A = (const bf16*)(ws + WS_WMIN) + (size_t)2048 * D; g.M = 1536; g.bdil = 1; }
                    pg8::StaticOrder S; S.init(g.M, g.N, F.G, (int)blockIdx.x); for (int pg_ = 0; pg_ < PROBE_GEMM; ++pg_) pg8::gemm_phase<pg8::EpiX, pg8::StaticOrder>(F.lds + RING_OFF, g, S, E); }
                SEAM();
            }
            if (!is_ffn && RUN(base + 2 * rep + 1)) {
                if (mix == 0) conv_phase(F, BIG, BIG + (size_t)M * 1024, args.in[9] + (size_t)mj * 3 * D);
                else if (mix == 1) { if (rep == 0) for (int pa_ = 0; pa_ < PROBE_ATT0; ++pa_) attn_mfma(F, 0); attn_mfma(F, rep); }
                else for (int ps_ = 0; ps_ < PROBE_MLS; ++ps_) mlstm_S_mfma(F);
                SEAM();
            }
        }
        if (!is_ffn && mix == 2 && RUN(base + 2)) { for (int po_ = 0; po_ < PROBE_MLO; ++po_) mlstm_O_mfma(F); SEAM(); }
        if (RUN(base + 6)) {
            pg8::Gemm g; g.M = M; g.N = D; g.bdil = 1; g.K = D; g.lda = D; g.ldb = D;
            if (is_ffn) { g.A = BIG; g.K = FF; g.lda = FF; g.ldb = FF; g.Bt = (const bf16*)(ws + WS_WDN) + (size_t)(layer * 2 + (sub >> 1)) * D * FF; }
            else if (mix == 0) { g.A = BIG; g.Bt = (const bf16*)(ws + WS_WCOUT) + (size_t)mj * D * D; }
            else if (mix == 1) { g.A = R2; g.lda = LDX; g.Bt = (const bf16*)(ws + WS_WAOUT); }
            else { g.A = BIG + (size_t)M * 1024; g.lda = D; g.Bt = (const bf16*)(ws + WS_WMOUT); }
            pg8::EpiX E; E.mode = 0; E.O = Y; E.ldc = D; E.O2 = nullptr; E.rope = rope; E.qscale = 1.f; E.rs = nullptr; E.rsm = 0; E.cdil = 1; E.gsh = 0;
            pg8::StaticOrder S; S.init(g.M, g.N, F.G, (int)blockIdx.x);
            for (int pg_ = 0; pg_ < (is_ffn ? PROBE_DOWN : 1) * PROBE_GEMM; ++pg_) pg8::gemm_phase<pg8::EpiX, pg8::StaticOrder>(F.lds + RING_OFF, g, S, E);
            SEAM();
        }
        if (RUN(base + 7)) {
            const float* gpost = args.in[1] + (size_t)(layer * 6 + 2 * sub + 1) * D;
            const bool last = (s == 11); const bool want_gates = (sub == 0 && mix == 2);
            for (int pt_ = 0; pt_ < PROBE_THIN; ++pt_) thin_phase(F, nullptr, XN, Y, gpost, 0.f, (float*)(ws + WS_RS), nullptr, nullptr, nullptr);
            thin_phase(F, nullptr, XN, Y, gpost, is_ffn ? 0.5f : 1.0f, (float*)(ws + WS_RS), last ? args.out : nullptr, want_gates ? (const float*)(ws + WS_GATEW) : nullptr, (float*)(ws + WS_GATES));
            SEAM();
        }
    }
#undef RUN
#undef SEAM
}

extern "C" void kernel_launch(void* const* d_in, const int* in_sizes, int n_in, void* d_out, int out_size, void* d_ws, size_t ws_size, hipStream_t stream) {
    static int grid = 0;
    if (grid == 0) {
        if (n_in != 17 || in_sizes[0] != M * D || out_size != M * D || ws_size < WS_END) { fprintf(stderr, "kernel_launch: unexpected shapes (n_in %d, in0 %d, out %d, ws %zu < %zu); nothing launched\n", n_in, n_in > 0 ? in_sizes[0] : -1, out_size, ws_size, (size_t)WS_END); grid = -1; return; }
        int dev = 0, cus = 0, per_cu = 0;
        if (hipGetDevice(&dev) != hipSuccess || hipDeviceGetAttribute(&cus, hipDeviceAttributeMultiprocessorCount, dev) != hipSuccess) { grid = -1; return; }
        if (hipFuncSetAttribute((const void*)mk_fwd, hipFuncAttributeMaxDynamicSharedMemorySize, LDS_BYTES) != hipSuccess) { fprintf(stderr, "kernel_launch: hipFuncSetAttribute failed\n"); grid = -1; return; }
        if (hipOccupancyMaxActiveBlocksPerMultiprocessor(&per_cu, (const void*)mk_fwd, NWAVES * 64, LDS_BYTES) != hipSuccess || per_cu < 1)
            fprintf(stderr, "kernel_launch: note: occupancy query reports %d workgroups per CU\n", per_cu);
        (void)hipGetLastError();
        grid = cus;
    }
    if (grid < 0) return;
    if (hipMemsetAsync((char*)d_ws + WS_CTL, 0, CTL_ZERO_BYTES, stream) != hipSuccess) return;
    Args a{};
    for (int i = 0; i < 17; ++i) a.in[i] = (const float*)d_in[i];
    a.out = (float*)d_out; a.ws = (unsigned char*)d_ws;
#if MK_SPLIT
    for (int id = 0; id < N_PHASE_IDS; ++id) { if (!phase_nonempty(id)) continue; a.ph_lo = id; a.ph_hi = id + 1;
        hipLaunchKernelGGL(mk_fwd, dim3(grid), dim3(NWAVES * 64), LDS_BYTES, stream, a); }
#else
    a.ph_lo = 0; a.ph_hi = N_PHASE_IDS;
    hipLaunchKernelGGL(mk_fwd, dim3(grid), dim3(NWAVES * 64), LDS_BYTES, stream, a);
#endif
    const hipError_t le = hipPeekAtLastError();
    if (le != hipSuccess) fprintf(stderr, "kernel_launch: launch failed: %s\n", hipGetErrorName(le));
}
```

```cpp
#include <hip/hip_runtime.h>
#include <cstdio>
#include <cstdint>
#include <cmath>
namespace pg8 {
#define PG8_LAS __attribute__((address_space(3)))
typedef unsigned short bf16_t;
typedef short bf16x8 __attribute__((ext_vector_type(8)));
typedef float f32x4 __attribute__((ext_vector_type(4)));
typedef unsigned u32x4 __attribute__((ext_vector_type(4)));
constexpr int BM = 256, BK = 64, HALF = 128, HTB = HALF * BK * 2  , STAGE_BYTES = 8 * HTB, NXCD = 8, WGM = 8;

__host__ __device__ __forceinline__ int lds_byte(int r, int c) { const int st = (r >> 4) * 2 + (c >> 5), rr = r & 15, cc = c & 31, ob = rr * 64 + cc * 2; return st * 1024 + (ob ^ (((ob >> 9) & 1) << 5)); }
__host__ __device__ __forceinline__ void stage_rc(int b, int& R, int& C) { const int st = b / 1024, sb = b % 1024, swz = sb ^ (((sb >> 9) & 1) << 5); R = (st >> 1) * 16 + swz / 64; C = (st & 1) * 32 + (swz % 64) / 2; }
__host__ __device__ __forceinline__ int perm32(int rho) { const int n = rho >> 4, i = rho & 15; return 8 * (i >> 2) + 4 * n + (i & 3); }

struct Unit { int pm, pn; };
struct StaticOrder {
    int nM, nN, nwg, G, c;
    __host__ __device__ void init(int M, int N, int G_, int c_) { nM = M / BM; nN = N / BM; nwg = nM * nN; G = G_; c = c_; }
    __host__ __device__ bool next(int i, Unit& u) const {
        const long L = (long)i * G + c; if (L >= nwg) return false;
        int wgid = (int)L; { const int q = nwg / NXCD, r = nwg % NXCD, xcd = wgid % NXCD, off = wgid / NXCD; wgid = (xcd < r ? xcd * (q + 1) : r * (q + 1) + (xcd - r) * q) + off; }
        const int nig = WGM * nN, gid = wgid / nig, fm = gid * WGM, gsz = (nM - fm) < WGM ? (nM - fm) : WGM;
        u.pm = fm + ((wgid % nig) % gsz); u.pn = (wgid % nig) / gsz; return true;
    }
    __device__ __forceinline__ void a_ready(const Unit&) const {}
    __device__ __forceinline__ void done(const Unit&) const {}
};
__device__ __forceinline__ unsigned cvt_pk_bf16(float lo, float hi) { unsigned r; asm volatile("v_cvt_pk_bf16_f32 %0, %1, %2" : "=v"(r) : "v"(lo), "v"(hi)); return r; }
typedef float f32x2 __attribute__((ext_vector_type(2)));

struct Gemm { const bf16_t* A; const bf16_t* Bt; int M, N, K, lda, ldb, bdil; };

__device__ __forceinline__ unsigned b_half_off(const Gemm& g, int pn, int h) {
    const int p0 = pn * BM + h * HALF; int row = p0;
    if (g.bdil != 1) { const int L = 2048 / g.bdil, b = p0 >> 11, pp = p0 & 2047, r = pp / L, u0 = pp - r * L; row = (b << 11) + u0 * g.bdil + r; }
    return (unsigned)row * (unsigned)g.ldb * 2u;
}

__device__ __forceinline__ f32x4 silu4(f32x4 v) {
    f32x4 o;
#pragma unroll
    for (int i = 0; i < 4; ++i) { const float e = __builtin_amdgcn_exp2f(v[i] * -1.4426950408889634f); o[i] = v[i] * __builtin_amdgcn_rcpf(1.0f + e); }
    return o;
}

struct EpiX {
    static constexpr bool PERM = true;
    int mode; bf16_t* O; int ldc; bf16_t* O2; const float* rope; float qscale;
    const float* rs; int rsm, cdil, gsh;
    __device__ __forceinline__ void store8(__amdgpu_buffer_rsrc_t rsrc, const bf16_t* p, const f32x4 v0, const f32x4 v1) const {
        u32x4 w; w.x = cvt_pk_bf16(v0[0], v0[1]); w.y = cvt_pk_bf16(v0[2], v0[3]); w.z = cvt_pk_bf16(v1[0], v1[1]); w.w = cvt_pk_bf16(v1[2], v1[3]);
        __builtin_amdgcn_raw_buffer_store_b128(w, rsrc, (int)((const char*)p - (const char*)O), 0, 16); }
    __device__ __forceinline__ void operator()(const f32x4 (&acc)[2][2][4][2], const Unit& u, int wr, int wc, int fr, int fq, const PG8_LAS float* rsl) const {
        const int row0 = u.pm * BM + wr * 64 + fr;
        const __amdgpu_buffer_rsrc_t rsrc = __builtin_amdgcn_make_buffer_rsrc((void*)O, 0, 0x7fffffff, 0x00020000);
        const bool pair = (mode == 1) || (mode == 2 && u.pn >= 4);
        if (pair) {
            bf16_t* base = (mode == 1) ? O : O2; const int pnn = (mode == 1) ? u.pn : u.pn - 4; const int ld = (mode == 1) ? ldc : 1024;
            const int col0 = pnn * HALF + wc * 32 + 8 * fq;
#pragma unroll
            for (int ai = 0; ai < 2; ++ai)
#pragma unroll
                for (int m = 0; m < 4; ++m) { const int row = row0 + ai * HALF + m * 16; bf16_t* rowp = base + (size_t)row * ld + col0; const float rsc = rsl[row - u.pm * BM], r2 = rsc * rsc;
                    const f32x4 a0 = acc[ai][0][m][0], a1 = acc[ai][0][m][1], b0 = acc[ai][1][m][0], b1 = acc[ai][1][m][1];
                    f32x4 o0 = (a0 * b0) * r2, o1 = (a1 * b1) * r2;
                    if (mode == 1) { const float k2 = -1.4426950408889634f * rsc; const f32x4 t0 = a0 * k2, t1 = a1 * k2; f32x4 e0, e1;
#pragma unroll
                        for (int i = 0; i < 4; ++i) { e0[i] = __builtin_amdgcn_exp2f(t0[i]); e1[i] = __builtin_amdgcn_exp2f(t1[i]); }
                        e0 = e0 + 1.0f; e1 = e1 + 1.0f;
#pragma unroll
                        for (int i = 0; i < 4; ++i) { e0[i] = __builtin_amdgcn_rcpf(e0[i]); e1[i] = __builtin_amdgcn_rcpf(e1[i]); }
                        o0 = o0 * e0; o1 = o1 * e1; }
                    store8(rsrc, rowp, o0, o1); }
        } else {
            const int col0 = u.pn * BM + wc * 32 + 8 * fq;
            float sc = 1.f; bool dorope = false;
            if (mode == 3) { if (u.pn < 4) sc = qscale; dorope = ((wc & 1) == 0); }
            if (mode == 4) { if (u.pn < 2) sc = qscale; }
            f32x4 cs[2][2];
#pragma unroll
            for (int bj = 0; bj < 2; ++bj) { cs[bj][0] = (f32x4){1.f, 1.f, 1.f, 1.f}; cs[bj][1] = cs[bj][0]; }
            if (rsm == 2) {
#pragma unroll
                for (int bj = 0; bj < 2; ++bj) { const int p0 = col0 + bj * HALF; int t0 = p0, st = 1;
                    if (cdil != 1) { const int L = 2048 / cdil, bb = p0 >> 11, pp = p0 & 2047, r = pp / L, u0 = pp - r * L; t0 = (bb << 11) + u0 * cdil + r; st = cdil; }
#pragma unroll
                    for (int e = 0; e < 4; ++e) { cs[bj][0][e] = rs[t0 + e * st]; cs[bj][1][e] = rs[t0 + (4 + e) * st]; } }
            }
#pragma unroll
            for (int ai = 0; ai < 2; ++ai)
#pragma unroll
                for (int m = 0; m < 4; ++m) { const int row = row0 + ai * HALF + m * 16; bf16_t* rowp = O + (size_t)row * ldc + col0; const float rsc = (rsm == 1) ? rsl[row - u.pm * BM] * sc : sc;
                    f32x4 c0 = (f32x4){1.f, 1.f, 1.f, 1.f}, c1 = c0, s0 = (f32x4){0.f, 0.f, 0.f, 0.f}, s1 = s0;
                    if (dorope) { const float* tp = rope + (size_t)(row & 2047) * 16; c0 = *(const f32x4*)(tp); c1 = *(const f32x4*)(tp + 4); s0 = *(const f32x4*)(tp + 8); s1 = *(const f32x4*)(tp + 12);
                        if (fq == 0) { s0 = -s0; s1 = -s1; } }
#pragma unroll
                    for (int bj = 0; bj < 2; ++bj) { f32x4 v0 = acc[ai][bj][m][0], v1 = acc[ai][bj][m][1];
                        if (dorope) { f32x4 p0, p1;
#pragma unroll
                            for (int e = 0; e < 4; ++e) { p0[e] = __shfl_xor(v0[e], 16); p1[e] = __shfl_xor(v1[e], 16); }
                            if (fq < 2) { v0 = v0 * c0 + p0 * s0; v1 = v1 * c1 + p1 * s1; } }
                        v0 = v0 * rsc * cs[bj][0]; v1 = v1 * rsc * cs[bj][1];
                        if (mode == 3 || (mode == 4 && u.pn < 4)) {
                            const int c0 = col0 + bj * HALF; size_t off;
                            if (mode == 3) { const int bb = row >> 11, tt = row & 2047, r = tt & ((1 << gsh) - 1), uu = tt >> gsh, tile = bb * 64 + (r << (6 - gsh)) + (uu >> 5);
                                const int sec = c0 >> 10, hc = c0 & 1023, hh = hc >> 6, dc = (hc >> 3) & 7;
                                off = (size_t)sec * ((size_t)16384 * 1024) + ((size_t)((tile * 16 + hh) * 4 + (dc >> 1)) * 512) + ((uu & 31) + 32 * (dc & 1)) * 8; }
                            else { const int tile = row >> 5, sec = c0 >> 9, hc = c0 & 511, hh = hc >> 7, dc = (hc >> 3) & 15;
                                off = (size_t)sec * ((size_t)16384 * 512) + ((size_t)((tile * 4 + hh) * 8 + (dc >> 1)) * 512) + ((row & 31) + 32 * (dc & 1)) * 8; }
                            store8(rsrc, O + off, v0, v1);
                        } else if (mode == 4) { store8(rsrc, O2 + (size_t)row * 1024 + (col0 + bj * HALF - 1024), v0, v1);
                        } else if (rsm == 2) {
                            const int p0 = col0 + bj * HALF; store8(rsrc, O + ((size_t)(row >> 5) * (size_t)(ldc >> 4) + (p0 >> 4)) * 512 + ((row & 31) + 32 * ((p0 >> 3) & 1)) * 8, v0, v1);
                        } else store8(rsrc, rowp + bj * HALF, v0, v1); } }
        }
    }
};

template <class Epi, class Sched>
__device__ __forceinline__ void gemm_phase(PG8_LAS unsigned char* lds, const Gemm g, const Sched& S, const Epi& E) {
    int tid = threadIdx.x; asm volatile("" : "+v"(tid));
    const int wid = __builtin_amdgcn_readfirstlane(tid >> 6), lane = tid & 63, wr = wid >> 2, wc = wid & 3, fr = lane & 15, fq = lane >> 4;
    const int K = g.K, nt = K / BK;
    unsigned voffA[2], voffB[2];
#pragma unroll
    for (int i = 0; i < 2; ++i) { int R, C; stage_rc(tid * 16 + i * 8192, R, C); const int Rb = Epi::PERM ? ((R & ~31) + perm32(R & 31)) : R;
        voffA[i] = (unsigned)(R * g.lda + C) * 2u; voffB[i] = (unsigned)(Rb * g.bdil * g.ldb + C) * 2u; }
    const unsigned kstep = (unsigned)(BK * 2);
    const unsigned hstepA = (unsigned)HALF * (unsigned)g.lda * 2u;
    const unsigned tstepA = 2u * hstepA;
    const char* const baseA = (const char*)g.A; const char* const baseB = (const char*)g.Bt;
    const unsigned ldsw = (unsigned)wid * 1024u;
    const int aoff = lds_byte(wr * 64 + fr, fq * 8), boff = lds_byte(wc * 32 + fr, fq * 8);
#define PG8_SA(b, h) (((b) * 2 + (h)) * HTB)
#define PG8_SB(b, h) ((4 + (b) * 2 + (h)) * HTB)
#define PG8_STAGE(bufoff, gbase, uoff, voff) do { _Pragma("unroll") for (int _i = 0; _i < 2; ++_i) \
        __builtin_amdgcn_global_load_lds((const unsigned*)((gbase) + (size_t)((unsigned)(uoff) + (voff)[_i])), (PG8_LAS unsigned*)(lds + (bufoff) + ldsw + _i * 8192), 16, 0, 0); } while (0)
#define PG8_LDA(dst, b, h) do { _Pragma("unroll") for (int m = 0; m < 4; ++m) _Pragma("unroll") for (int k = 0; k < 2; ++k) dst[m][k] = *(const PG8_LAS bf16x8*)(lds + PG8_SA(b, h) + aoff + m * 2048 + k * 1024); } while (0)
#define PG8_LDB(dst, b, h) do { _Pragma("unroll") for (int n = 0; n < 2; ++n) _Pragma("unroll") for (int k = 0; k < 2; ++k) dst[n][k] = *(const PG8_LAS bf16x8*)(lds + PG8_SB(b, h) + boff + n * 2048 + k * 1024); } while (0)
#define PG8_MMA(ai, bj, At, Bt) do { __builtin_amdgcn_s_setprio(1); _Pragma("unroll") for (int m = 0; m < 4; ++m) _Pragma("unroll") for (int n = 0; n < 2; ++n) _Pragma("unroll") for (int k = 0; k < 2; ++k) \
        acc[ai][bj][m][n] = __builtin_amdgcn_mfma_f32_16x16x32_bf16(Bt[n][k], At[m][k], acc[ai][bj][m][n], 0, 0, 0); __builtin_amdgcn_s_setprio(0); } while (0)
#ifndef PROBE_XMFMA
#define PROBE_XMFMA 0
#endif
#define PG8_XMMA() do { const bf16x8 z_ = (bf16x8){0, 0, 0, 0, 0, 0, 0, 0}; _Pragma("unroll") for (int x_ = 0; x_ < PROBE_XMFMA; ++x_) acc[1][1][x_ & 3][(x_ >> 2) & 1] = __builtin_amdgcn_mfma_f32_16x16x32_bf16(z_, At[x_ & 3][0], acc[1][1][x_ & 3][(x_ >> 2) & 1], 0, 0, 0); } while (0)
#ifndef PG8_ALIGN_EPI
#define PG8_ALIGN_EPI 1
#endif
#define PG8_WAIT_V(n) asm volatile("s_waitcnt vmcnt(" #n ")" ::: "memory")
#define PG8_WAIT_L(n) asm volatile("s_waitcnt lgkmcnt(" #n ")" ::: "memory")
#define PG8_BAR __builtin_amdgcn_s_barrier()
#define PG8_SCHED __builtin_amdgcn_sched_barrier(0)
    Unit cur, nxt; int ui = 0;
    if (!S.next(0, cur)) return;
    f32x4 acc[2][2][4][2];
#pragma unroll
    for (int a = 0; a < 2; ++a)
#pragma unroll
        for (int b = 0; b < 2; ++b)
#pragma unroll
            for (int m = 0; m < 4; ++m)
#pragma unroll
                for (int n = 0; n < 2; ++n) acc[a][b][m][n] = (f32x4){0.f, 0.f, 0.f, 0.f};
    bf16x8 At[4][2], B0[2][2], B1[2][2];
    unsigned cA = (unsigned)cur.pm * tstepA, cB0 = b_half_off(g, cur.pn, 0), cB1 = b_half_off(g, cur.pn, 1);
#define PG8_RSL(par) ((PG8_LAS float*)(lds + STAGE_BYTES + 2048 + (par) * 1024))
#define PG8_STAGE_RS(un, par) do { if (E.rsm == 1 && wid < 4) __builtin_amdgcn_global_load_lds((const unsigned*)(E.rs + (size_t)(un).pm * BM + wid * 64 + lane), (PG8_LAS unsigned*)(PG8_RSL(par) + wid * 64), 4, 0, 0); } while (0)
    PG8_STAGE_RS(cur, 0);
    PG8_STAGE(PG8_SB(0, 0), baseB, cB0, voffB); PG8_STAGE(PG8_SB(0, 1), baseB, cB1, voffB); PG8_STAGE(PG8_SA(0, 0), baseA, cA, voffA); PG8_STAGE(PG8_SA(0, 1), baseA, cA + hstepA, voffA);
    if (wr == 1) PG8_BAR;
    PG8_WAIT_V(2); PG8_BAR;
    PG8_STAGE(PG8_SB(1, 0), baseB, cB0 + kstep, voffB); PG8_STAGE(PG8_SA(1, 0), baseA, cA + kstep, voffA); PG8_STAGE(PG8_SB(1, 1), baseB, cB1 + kstep, voffB);
    PG8_WAIT_V(6); PG8_BAR;
    for (;;) {
        const bool has_next = S.next(ui + 1, nxt);
        const unsigned nA = has_next ? (unsigned)nxt.pm * tstepA : cA;
        const unsigned nB0 = has_next ? b_half_off(g, nxt.pn, 0) : cB0, nB1 = has_next ? b_half_off(g, nxt.pn, 1) : cB1;
        for (int t = 0; t < nt; t += 2) {
            const bool last = (t == nt - 2);
            const unsigned a1 = cA + (unsigned)(t + 1) * kstep;
            const unsigned a2 = last ? nA : cA + (unsigned)(t + 2) * kstep;
            const unsigned b2_0 = last ? nB0 : cB0 + (unsigned)(t + 2) * kstep, b2_1 = last ? nB1 : cB1 + (unsigned)(t + 2) * kstep;
            const unsigned a3 = a2 + kstep, b3_0 = b2_0 + kstep, b3_1 = b2_1 + kstep;
            PG8_LDB(B0, 0, 0); PG8_LDB(B1, 0, 1); PG8_SCHED; PG8_LDA(At, 0, 0); PG8_STAGE(PG8_SA(1, 1), baseA, a1 + hstepA, voffA);
            PG8_WAIT_V(8); PG8_WAIT_L(0); PG8_BAR; PG8_MMA(0, 0, At, B0); PG8_MMA(0, 1, At, B1); PG8_BAR; PG8_SCHED;
            PG8_LDA(At, 0, 1); PG8_STAGE(PG8_SB(0, 0), baseB, b2_0, voffB); PG8_STAGE(PG8_SB(0, 1), baseB, b2_1, voffB); PG8_STAGE(PG8_SA(0, 0), baseA, a2, voffA);
            PG8_WAIT_V(8); PG8_WAIT_L(0); PG8_BAR; PG8_MMA(1, 0, At, B0); PG8_MMA(1, 1, At, B1); PG8_XMMA(); PG8_BAR; PG8_SCHED;
            PG8_LDB(B0, 1, 0); PG8_LDB(B1, 1, 1); PG8_SCHED; PG8_LDA(At, 1, 0); PG8_STAGE(PG8_SA(0, 1), baseA, a2 + hstepA, voffA);
            PG8_WAIT_V(8); PG8_WAIT_L(0); PG8_BAR; PG8_MMA(0, 0, At, B0); PG8_MMA(0, 1, At, B1); PG8_BAR; PG8_SCHED;
            PG8_LDA(At, 1, 1); PG8_STAGE(PG8_SB(1, 0), baseB, b3_0, voffB); PG8_STAGE(PG8_SB(1, 1), baseB, b3_1, voffB); PG8_STAGE(PG8_SA(1, 0), baseA, a3, voffA);
            PG8_WAIT_V(8); PG8_WAIT_L(0); PG8_BAR; PG8_MMA(1, 0, At, B0); PG8_MMA(1, 1, At, B1); PG8_XMMA(); PG8_BAR; PG8_SCHED;
        }
        if (PG8_ALIGN_EPI) { if (wr == 0) PG8_BAR; }
        E(acc, cur, wr, wc, fr, fq, PG8_RSL(ui & 1));
        if (!has_next) break;
#pragma unroll
        for (int a = 0; a < 2; ++a)
#pragma unroll
            for (int b = 0; b < 2; ++b)
#pragma unroll
                for (int m = 0; m < 4; ++m)
#pragma unroll
                    for (int n = 0; n < 2; ++n) acc[a][b][m][n] = (f32x4){0.f, 0.f, 0.f, 0.f};
        cur = nxt; cA = nA; cB0 = nB0; cB1 = nB1; ++ui;
        PG8_STAGE_RS(cur, ui & 1);
        if (PG8_ALIGN_EPI) { if (wr == 1) PG8_BAR; }
    }
    PG8_WAIT_V(0);
    if (!PG8_ALIGN_EPI) { if (wr == 0) PG8_BAR; }
    PG8_BAR;
#undef PG8_RSL
#undef PG8_STAGE_RS
#undef PG8_SA
#undef PG8_SB
#undef PG8_STAGE
#undef PG8_LDA
#undef PG8_LDB
#undef PG8_MMA
#undef PG8_XMMA
#undef PG8_WAIT_V
#undef PG8_WAIT_L
#undef PG8_BAR
#undef PG8_SCHED
}
}
#define GAS __attribute__((address_space(1)))
#define LAS __attribute__((address_space(3)))
typedef unsigned short bf16;
typedef unsigned v4u __attribute__((ext_vector_type(4)));
typedef float f32x4 __attribute__((ext_vector_type(4)));
typedef short bf16x8 __attribute__((ext_vector_type(8)));
typedef GAS unsigned gu32;
typedef GAS unsigned long long gu64;
#define RLX_AGENT __ATOMIC_RELAXED, __HIP_MEMORY_SCOPE_AGENT
#define LDS_WAIT() asm volatile("s_waitcnt lgkmcnt(0)" ::: "memory")
#define VM_WAIT() asm volatile("s_waitcnt vmcnt(0)" ::: "memory")
__device__ __forceinline__ unsigned long long rt() { return __builtin_amdgcn_s_memrealtime(); }
__device__ __forceinline__ unsigned f2bf(float f) { unsigned u = __builtin_bit_cast(unsigned, f); return (u + 0x7fffu + ((u >> 16) & 1u)) >> 16; }
__device__ __forceinline__ unsigned pk2(float lo, float hi) { return f2bf(lo) | (f2bf(hi) << 16); }

#define XB_TMO      128
#define XB_XCNT(j)  (256  + 64 * (j))
#define XB_XSUB(j)  (1280 + 64 * (j))
#define XB_XGEN(j)  (2304 + 64 * (j))
#define XB_TOP      3328
#define XB_TOPGEN   3392
#define XCD_BAR_WORDS 3456
#define XB_SPIN_CAP (1u << 18)

__device__ __forceinline__ unsigned xb_ld(unsigned* p)              { return __hip_atomic_load(p, __ATOMIC_RELAXED, __HIP_MEMORY_SCOPE_AGENT); }
__device__ __forceinline__ unsigned xb_add(unsigned* p, unsigned v) { return __hip_atomic_fetch_add(p, v, __ATOMIC_RELAXED, __HIP_MEMORY_SCOPE_AGENT); }
__device__ __forceinline__ unsigned xb_xcc_id() { return (unsigned)__builtin_amdgcn_s_getreg((3 << 11) | 20) & 0xFu; }
#define XB_SPIN(cond, bar) do { unsigned _sp = 0; while (cond) { __builtin_amdgcn_s_sleep(1); \
    if ((++_sp & 255u) == 0u) { if (xb_ld(&(bar)[XB_TMO])) break; if (_sp > XB_SPIN_CAP) { atomicAdd(&(bar)[XB_TMO], 1u); break; } } } } while (0)

struct XcdBarrier {
    unsigned* bar; unsigned x;
    volatile LAS unsigned* st;
};

__device__ __forceinline__ XcdBarrier xcd_barrier_post(unsigned* bar, volatile LAS unsigned* st) {
    XcdBarrier b; b.bar = bar; b.x = xb_xcc_id(); b.st = st;
    if (threadIdx.x == 0) (void)xb_add(&bar[XB_XCNT(b.x)], 1u);
    return b;
}
__device__ __forceinline__ void xcd_barrier_complete(unsigned* bar, unsigned x, unsigned& nloc, unsigned& nx) {
    const unsigned G = gridDim.x * gridDim.y * gridDim.z;
    unsigned sum, cnt, mine, sp = 0u;
    for (;;) {
        sum = 0u; cnt = 0u; mine = 0u;
#pragma unroll
        for (unsigned j = 0; j < 16; ++j) { const unsigned c = xb_ld(&bar[XB_XCNT(j)]); sum += c; cnt += (c > 0u) ? 1u : 0u; mine = (j == x) ? c : mine; }
        if (sum == G) break;
        __builtin_amdgcn_s_sleep(1);
        if ((++sp & 255u) == 0u) { if (xb_ld(&bar[XB_TMO])) break; if (sp > XB_SPIN_CAP) { atomicAdd(&bar[XB_TMO], 1u); break; } }
    }
    nloc = mine > 0u ? mine : 1u; nx = cnt > 0u ? cnt : 1u;
}

__device__ __forceinline__ void xcd_barrier(const XcdBarrier& b) {
    asm volatile("s_waitcnt vmcnt(0)" ::: "memory");
    __syncthreads();
    if (threadIdx.x == 0) {
        unsigned* bar = b.bar;
        __builtin_amdgcn_s_waitcnt(0);
        unsigned nloc = b.st[0], nx = b.st[1];
        if (nloc == 0u) { xcd_barrier_complete(bar, b.x, nloc, nx); b.st[0] = nloc; b.st[1] = nx; }
        const unsigned old = xb_add(&bar[XB_XSUB(b.x)], 1u);
        const unsigned gen = old / nloc;
        if (old + 1u == (gen + 1u) * nloc) {
            __builtin_amdgcn_fence(__ATOMIC_RELEASE, "agent");
            asm volatile("s_waitcnt vmcnt(0)" ::: "memory");
            const unsigned og = xb_add(&bar[XB_TOP], 1u);
            const unsigned tg = og / nx;
            if (og + 1u == (tg + 1u) * nx) xb_add(&bar[XB_TOPGEN], 1u);
            else XB_SPIN(xb_ld(&bar[XB_TOPGEN]) == tg, bar);
            __builtin_amdgcn_fence(__ATOMIC_ACQUIRE, "agent");
            xb_add(&bar[XB_XGEN(b.x)], 1u);
            asm volatile("s_waitcnt vmcnt(0)" ::: "memory");
        } else {
            XB_SPIN(xb_ld(&bar[XB_XGEN(b.x)]) == gen, bar);
            __builtin_amdgcn_fence(__ATOMIC_ACQUIRE, "agent");
            asm volatile("s_waitcnt vmcnt(0)" ::: "memory");
        }
    }
    __syncthreads();
}

constexpr int NWAVES = 8;
constexpr int BATCH = 8, SEQ = 2048, D = 1024, FF = 2816, DEPTH = 4;
constexpr int M = BATCH * SEQ;
constexpr float EPS = 1e-6f;
constexpr int ML_PROJ = 3080;
constexpr float ATT_QSCALE = 0.125f * 1.4426950408889634f;
constexpr int LDX = D + 64;
constexpr int LDQ = 2048 + 64;
constexpr int LDT = M + 64;
constexpr float ML_QSCALE = 0.08838834764831845f;

constexpr size_t MiB = 1u << 20;
constexpr size_t WS_CTL = 0, CTL_ZERO_BYTES = 32768;
constexpr size_t WS_ROPE = 1 * MiB;
constexpr size_t WS_GATEW = WS_ROPE + 256 * 1024;
constexpr size_t WS_GATES = WS_ROPE + 512 * 1024;
constexpr size_t WS_LSE = 2 * MiB;
constexpr size_t WS_NST = 3 * MiB;
constexpr size_t WS_MST = 3 * MiB + 512 * 1024;
constexpr size_t WS_RS = 5 * MiB;
constexpr size_t WS_GV = 4 * MiB;
constexpr size_t WS_WUP = 8 * MiB;
constexpr size_t WS_WDN = 96 * MiB;
constexpr size_t WS_WCIN = 140 * MiB;
constexpr size_t WS_WCOUT = 152 * MiB;
constexpr size_t WS_WAIN = 156 * MiB;
constexpr size_t WS_WAOUT = 174 * MiB;
constexpr size_t WS_WMIN = 176 * MiB;
constexpr size_t WS_WMOUT = 183 * MiB;
constexpr size_t WS_XN = 186 * MiB;
constexpr size_t WS_BIG = 220 * MiB;
constexpr size_t WS_TR = WS_BIG + 66 * MiB;
constexpr size_t WS_Y = WS_BIG + 88 * MiB;
constexpr size_t WS_R2 = 340 * MiB;
constexpr size_t WS_END = 406 * MiB;
static_assert((size_t)M * LDX * 2 <= 34 * MiB && (size_t)M * LDQ * 2 <= 66 * MiB && (size_t)1536 * LDT * 2 <= 54 * MiB, "d_ws map");
constexpr int CW_BAR = 4096;

constexpr int RING_OFF = 0, RING_BYTES = 131072;
constexpr int LDS_BYTES = 147456;
constexpr int MISC_OFF = LDS_BYTES - 512;

struct Args { const float* in[17]; float* out; unsigned char* ws; int ph_lo, ph_hi; };

struct Frame {
    LAS unsigned char* lds;
    volatile LAS unsigned* MISC;
    gu32* ctl;
    int vcu, G;
    unsigned char* ws;
};
struct LaneId { int tid, lane, wave; };
__device__ __forceinline__ LaneId lane_id() { int t = threadIdx.x; asm volatile("" : "+v"(t)); LaneId L; L.tid = t; L.lane = t & 63; L.wave = __builtin_amdgcn_readfirstlane(t >> 6); return L; }

__device__ __forceinline__ float wave_sum(float v) {
#pragma unroll
    for (int o = 1; o < 64; o <<= 1) v += __shfl_xor(v, o);
    return v;
}
__device__ __forceinline__ float wave_max(float v) {
#pragma unroll
    for (int o = 1; o < 64; o <<= 1) v = fmaxf(v, __shfl_xor(v, o));
    return v;
}
__device__ __forceinline__ float wave_incl_sum(float v, int lane) {
#pragma unroll
    for (int o = 1; o < 64; o <<= 1) { const float t = __shfl_up(v, o); if (lane >= o) v += t; }
    return v;
}
__device__ __forceinline__ float wave_incl_max(float v, int lane) {
#pragma unroll
    for (int o = 1; o < 64; o <<= 1) { const float t = __shfl_up(v, o); if (lane >= o) v = fmaxf(v, t); }
    return v;
}
__device__ __forceinline__ float bflo(unsigned w) { return __uint_as_float(w << 16); }
__device__ __forceinline__ float bfhi(unsigned w) { return __uint_as_float(w & 0xffff0000u); }
__device__ __forceinline__ float bf2f(bf16 u) { return __uint_as_float((unsigned)u << 16); }
__device__ __forceinline__ float dot8(const v4u a, const v4u b, float acc) {
    acc += bflo(a.x) * bflo(b.x); acc += bfhi(a.x) * bfhi(b.x); acc += bflo(a.y) * bflo(b.y); acc += bfhi(a.y) * bfhi(b.y);
    acc += bflo(a.z) * bflo(b.z); acc += bfhi(a.z) * bfhi(b.z); acc += bflo(a.w) * bflo(b.w); acc += bfhi(a.w) * bfhi(b.w); return acc;
}
__device__ __forceinline__ float bfel(const v4u a, int i) { const unsigned w = a[i >> 1]; return (i & 1) ? bfhi(w) : bflo(w); }
__device__ __forceinline__ float ld_f32_coherent(const float* p) { return __uint_as_float(__hip_atomic_load((const unsigned*)p, RLX_AGENT)); }
__device__ __forceinline__ float logsigmoid_f(float x) { return fminf(x, 0.f) - log1pf(expf(-fabsf(x))); }

__device__ __forceinline__ void thin_phase(Frame& F, const float* xin, bf16* X, const bf16* y, const float* gpost, float pscale, float* rs, float* fout, const float* gatew, float* gates) {
    const LaneId li = lane_id(); const int gw = F.vcu * NWAVES + li.wave, NGW = F.G * NWAVES, lane = li.lane;
    const __amdgpu_buffer_rsrc_t xrsrc = __builtin_amdgcn_make_buffer_rsrc((void*)X, 0, 0x7fffffff, 0x00020000);
    f32x4 gp[4];
#pragma unroll
    for (int i = 0; i < 4; ++i) { const int col = 512 * (i >> 1) + 8 * lane + 4 * (i & 1); gp[i] = gpost ? *(const f32x4*)(gpost + col) : (f32x4){0.f, 0.f, 0.f, 0.f}; }
    for (int m0 = gw; m0 < M; m0 += 2 * NGW) {
        f32x4 xv[2][4]; f32x4 yf[2][4];
#pragma unroll
        for (int rr = 0; rr < 2; ++rr) { const int m = (m0 + rr * NGW < M) ? m0 + rr * NGW : m0;
            if (xin) {
#pragma unroll
                for (int i = 0; i < 4; ++i) xv[rr][i] = __builtin_nontemporal_load((const GAS f32x4*)(xin + (size_t)m * D + 512 * (i >> 1) + 8 * lane + 4 * (i & 1)));
            } else {
#pragma unroll
                for (int j = 0; j < 2; ++j) { const v4u w = *(const GAS v4u*)(X + (size_t)m * LDX + 512 * j + 8 * lane);
                    xv[rr][2 * j] = (f32x4){bflo(w.x), bfhi(w.x), bflo(w.y), bfhi(w.y)}; xv[rr][2 * j + 1] = (f32x4){bflo(w.z), bfhi(w.z), bflo(w.w), bfhi(w.w)}; }
            }
            if (y) {
#pragma unroll
                for (int j = 0; j < 2; ++j) { const v4u w = __builtin_nontemporal_load((const GAS v4u*)(y + (size_t)m * D + 512 * j + 8 * lane));
                    yf[rr][2 * j] = (f32x4){bflo(w.x), bfhi(w.x), bflo(w.y), bfhi(w.y)}; yf[rr][2 * j + 1] = (f32x4){bflo(w.z), bfhi(w.z), bflo(w.w), bfhi(w.w)}; }
            }
        }
        if (y) {
            float ssq[2];
#pragma unroll
            for (int rr = 0; rr < 2; ++rr) { ssq[rr] = 0.f;
#pragma unroll
                for (int i = 0; i < 4; ++i) ssq[rr] += (yf[rr][i].x * yf[rr][i].x + yf[rr][i].y * yf[rr][i].y) + (yf[rr][i].z * yf[rr][i].z + yf[rr][i].w * yf[rr][i].w); }
#pragma unroll
            for (int o = 1; o < 64; o <<= 1) { ssq[0] += __shfl_xor(ssq[0], o); ssq[1] += __shfl_xor(ssq[1], o); }
#pragma unroll
            for (int rr = 0; rr < 2; ++rr) { const float r1 = pscale / sqrtf(ssq[rr] * (1.f / D) + EPS);
#pragma unroll
                for (int i = 0; i < 4; ++i) xv[rr][i] = xv[rr][i] + yf[rr][i] * gp[i] * r1; }
        }
        if (fout) {
#pragma unroll
            for (int rr = 0; rr < 2; ++rr) { const int m = m0 + rr * NGW; if (m < M) {
#pragma unroll
                for (int i = 0; i < 4; ++i) *(GAS f32x4*)(fout + (size_t)m * D + 512 * (i >> 1) + 8 * lane + 4 * (i & 1)) = xv[rr][i]; } }
        } else {
            float ssq[2];
#pragma unroll
            for (int rr = 0; rr < 2; ++rr) { ssq[rr] = 0.f;
#pragma unroll
                for (int i = 0; i < 4; ++i) ssq[rr] += (xv[rr][i].x * xv[rr][i].x + xv[rr][i].y * xv[rr][i].y) + (xv[rr][i].z * xv[rr][i].z + xv[rr][i].w * xv[rr][i].w); }
#pragma unroll
            for (int o = 1; o < 64; o <<= 1) { ssq[0] += __shfl_xor(ssq[0], o); ssq[1] += __shfl_xor(ssq[1], o); }
#pragma unroll
            for (int rr = 0; rr < 2; ++rr) { const int m = m0 + rr * NGW; if (m < M) {
                const float r2 = 1.f / sqrtf(ssq[rr] * (1.f / D) + EPS);
#pragma unroll
                for (int j = 0; j < 2; ++j) { v4u w; w.x = pk2(xv[rr][2 * j].x, xv[rr][2 * j].y); w.y = pk2(xv[rr][2 * j].z, xv[rr][2 * j].w); w.z = pk2(xv[rr][2 * j + 1].x, xv[rr][2 * j + 1].y); w.w = pk2(xv[rr][2 * j + 1].z, xv[rr][2 * j + 1].w);
                    __builtin_amdgcn_raw_buffer_store_b128(w, xrsrc, (int)(((size_t)m * LDX + 512 * j + 8 * lane) * 2), 0, 16); }
                if (lane == 0) rs[m] = r2;
                if (gatew) {
                    float mine = 0.f;
#pragma unroll
                    for (int jg = 0; jg < 8; ++jg) { float s = 0.f;
#pragma unroll
                        for (int i = 0; i < 4; ++i) { const f32x4 wv = *(const GAS f32x4*)(gatew + jg * D + 512 * (i >> 1) + 8 * lane + 4 * (i & 1)); s += (xv[rr][i].x * wv.x + xv[rr][i].y * wv.y) + (xv[rr][i].z * wv.z + xv[rr][i].w * wv.w); }
                        s = wave_sum(s); if (lane == jg) mine = s * r2; }
                    if (lane < 8) gates[(size_t)m * 8 + lane] = mine;
                }
            } }
        }
    }
}

__device__ __forceinline__ void conv_phase(Frame& F, bf16* Bz, const bf16* CU, const float* ck) {
    const LaneId li = lane_id(); const int gw = F.vcu * NWAVES + li.wave, NGW = F.G * NWAVES, lane = li.lane;
    f32x4 kk[3][4];
#pragma unroll
    for (int l = 0; l < 3; ++l)
#pragma unroll
        for (int i = 0; i < 4; ++i) kk[l][i] = *(const f32x4*)(ck + l * D + 512 * (i >> 1) + 8 * lane + 4 * (i & 1));
    const int per = (M + NGW - 1) / NGW;
    const int m_lo = gw * per, m_hi = (m_lo + per < M) ? m_lo + per : M;
    v4u c1[2], c2[2];
#pragma unroll
    for (int j = 0; j < 2; ++j) { c1[j] = (v4u){0u, 0u, 0u, 0u}; c2[j] = c1[j]; }
    if (m_lo < M) { const int t0 = m_lo & (SEQ - 1);
#pragma unroll
        for (int j = 0; j < 2; ++j) { const size_t off = (size_t)m_lo * D + 512 * j + 8 * lane;
            if (t0 >= 1) c1[j] = *(const GAS v4u*)(CU + off - D);
            if (t0 >= 2) c2[j] = *(const GAS v4u*)(CU + off - 2 * D); } }
    for (int m = m_lo; m < m_hi; ++m) {
        if ((m & (SEQ - 1)) == 0) {
#pragma unroll
            for (int j = 0; j < 2; ++j) { c1[j] = (v4u){0u, 0u, 0u, 0u}; c2[j] = c1[j]; } }
#pragma unroll
        for (int j = 0; j < 2; ++j) {
            const size_t off = (size_t)m * D + 512 * j + 8 * lane;
            const v4u bw = *(const GAS v4u*)(Bz + off); const v4u c0 = *(const GAS v4u*)(CU + off);
            float z[8];
#pragma unroll
            for (int e = 0; e < 8; ++e) { const f32x4 k0 = kk[0][2 * j + (e >> 2)], k1 = kk[1][2 * j + (e >> 2)], k2 = kk[2][2 * j + (e >> 2)];
                z[e] = bfel(bw, e) * (k0[e & 3] * bfel(c0, e) + k1[e & 3] * bfel(c1[j], e) + k2[e & 3] * bfel(c2[j], e)); }
            v4u w; w.x = pk2(z[0], z[1]); w.y = pk2(z[2], z[3]); w.z = pk2(z[4], z[5]); w.w = pk2(z[6], z[7]);
            *(GAS v4u*)(Bz + off) = w;
            c2[j] = c1[j]; c1[j] = c0;
        }
    }
}

__device__ __forceinline__ void transpose_tile(const float* src, int ld, int k0, int n0, bf16* dst, int Kd, LAS float* scr, int lane, const float* gk) {
    f32x4 v[16]; float gv[16];
#pragma unroll
    for (int i = 0; i < 16; ++i) { const int kk = 4 * i + (lane >> 4), c4 = (lane & 15) * 4;
        v[i] = __builtin_nontemporal_load((const f32x4*)(src + (size_t)(k0 + kk) * ld + n0 + c4)); gv[i] = gk ? gk[k0 + kk] : 1.0f; }
#pragma unroll
    for (int i = 0; i < 16; ++i) { const int kk = 4 * i + (lane >> 4), c4 = (lane & 15) * 4; const f32x4 w = v[i] * gv[i];
        scr[kk * 65 + c4 + 0] = w.x; scr[kk * 65 + c4 + 1] = w.y; scr[kk * 65 + c4 + 2] = w.z; scr[kk * 65 + c4 + 3] = w.w; }
    LDS_WAIT(); asm volatile("" ::: "memory");
    const int c = lane & 7;
#pragma unroll
    for (int j = 0; j < 8; ++j) { const int n = (lane >> 3) + 8 * j; const LAS float* s = scr + (8 * c) * 65 + n;
        v4u o; o.x = pk2(s[0 * 65], s[1 * 65]); o.y = pk2(s[2 * 65], s[3 * 65]); o.z = pk2(s[4 * 65], s[5 * 65]); o.w = pk2(s[6 * 65], s[7 * 65]);
        *(GAS v4u*)(dst + (size_t)n * Kd + k0 + 8 * c) = o; }
    LDS_WAIT(); asm volatile("" ::: "memory");
}

constexpr int CV_UP = 16 * 704, CV_DN = 8 * 704, CV_CIN = 2 * 768, CV_COUT = 2 * 256, CV_AIN = 2304, CV_AOUT = 256, CV_MIN = 896, CV_MOUT = 256;
constexpr int CV_O_DN = CV_UP, CV_O_CIN = CV_O_DN + CV_DN, CV_O_COUT = CV_O_CIN + CV_CIN, CV_O_ATT = CV_O_COUT + CV_COUT, CV_O_ML = CV_O_ATT + CV_AIN + CV_AOUT;
__device__ __forceinline__ void convert_range(Frame& F, const Args& a, int lo, int n, int wrank, int nw) {
    const LaneId li = lane_id();
    LAS float* scr = (LAS float*)(F.lds + li.wave * 16640);
    const int lane = li.lane;
    unsigned char* ws = F.ws;
    constexpr int N_UP = CV_UP, N_DN = CV_DN, N_CIN = CV_CIN, N_COUT = CV_COUT, N_AIN = CV_AIN, N_AOUT = CV_AOUT, N_MIN = CV_MIN;
    for (int it = lo + wrank; it < lo + n; it += nw) {
        int r = it; const float* src; int ld, K, kb, n0; bf16* dst; const float* gk = nullptr;
        if (r < N_UP) { const int mtx = r / 704; r -= mtx * 704; const int l = mtx >> 2, f = (mtx >> 1) & 1, which = mtx & 1;
            src = a.in[2 + 3 * f + which] + (size_t)l * D * FF; ld = FF; K = D; kb = r / 44; n0 = (r - kb * 44) * 64; gk = a.in[1] + (size_t)(l * 6 + 4 * f) * D;
            dst = (bf16*)(ws + WS_WUP) + (size_t)(l * 2 + f) * (2 * FF) * D + (size_t)(256 * (n0 >> 7) + (n0 & 127) + which * 128) * D; }
        else if ((r -= N_UP) < N_DN) { const int mtx = r / 704; r -= mtx * 704; const int l = mtx >> 1, f = mtx & 1;
            src = a.in[4 + 3 * f] + (size_t)l * FF * D; ld = D; K = FF; kb = r >> 4; n0 = (r & 15) * 64;
            dst = (bf16*)(ws + WS_WDN) + (size_t)(l * 2 + f) * D * FF + (size_t)n0 * FF; }
        else if ((r -= N_DN) < N_CIN) { const int j = r / 768; r -= j * 768;
            src = a.in[8] + (size_t)j * D * 3072; ld = 3072; K = D; kb = r / 48; n0 = (r - kb * 48) * 64; gk = a.in[1] + (size_t)((3 * j) * 6 + 2) * D;
            int drow = n0; if (n0 >= 2048) { const int f = n0 - 2048; drow = 1024 + 256 * (f >> 7) + 128 + (f & 127); } else if (n0 >= 1024) { const int f = n0 - 1024; drow = 1024 + 256 * (f >> 7) + (f & 127); }
            dst = (bf16*)(ws + WS_WCIN) + (size_t)j * 3072 * D + (size_t)drow * D; }
        else if ((r -= N_CIN) < N_COUT) { const int j = r >> 8; r &= 255;
            src = a.in[10] + (size_t)j * D * D; ld = D; K = D; kb = r >> 4; n0 = (r & 15) * 64;
            dst = (bf16*)(ws + WS_WCOUT) + (size_t)j * D * D + (size_t)n0 * D; }
        else if ((r -= N_COUT) < N_AIN) { src = a.in[11]; ld = 9216; K = D; kb = r / 144; n0 = (r - kb * 144) * 64; gk = a.in[1] + (size_t)(1 * 6 + 2) * D;
            dst = (bf16*)(ws + WS_WAIN) + (size_t)n0 * D; }
        else if ((r -= N_AIN) < N_AOUT) { src = a.in[12]; ld = D; K = D; kb = r >> 4; n0 = (r & 15) * 64;
            dst = (bf16*)(ws + WS_WAOUT) + (size_t)n0 * D; }
        else if ((r -= N_AOUT) < N_MIN) { src = a.in[13]; ld = ML_PROJ; K = D; kb = r / 56; const int gi = r - kb * 56; int drow; gk = a.in[1] + (size_t)(2 * 6 + 2) * D;
            if (gi < 16) { n0 = gi * 64; drow = n0; }
            else if (gi < 32) { n0 = 2048 + (gi - 16) * 64; drow = 1024 + (gi - 16) * 64; }
            else if (gi < 40) { n0 = 512 + (gi - 32) * 64; drow = 2048 + (gi - 32) * 64; }
            else { n0 = 1024 + (gi - 40) * 64; drow = 2560 + (gi - 40) * 64; }
            dst = (bf16*)(ws + WS_WMIN) + (size_t)drow * D; }
        else { r -= N_MIN; src = a.in[16]; ld = D; K = D; kb = r >> 4; n0 = (r & 15) * 64;
            dst = (bf16*)(ws + WS_WMOUT) + (size_t)n0 * D; }
        transpose_tile(src, ld, kb * 64, n0, dst, K, scr, lane, gk);
    }
}
__device__ __forceinline__ void convert_ffn(Frame& F, const Args& a, int l, int f, int wrank, int nw) {
    convert_range(F, a, (l * 4 + f * 2) * 704, 1408, wrank, nw); convert_range(F, a, CV_O_DN + (l * 2 + f) * 704, 704, wrank, nw);
}

__device__ __forceinline__ void prologue(Frame& F, const Args& a) {
    const LaneId li = lane_id();
    const int gw = F.vcu * NWAVES + li.wave, NGW = F.G * NWAVES, lane = li.lane;
    unsigned char* ws = F.ws;
    convert_ffn(F, a, 0, 0, gw, NGW);
    { const int gt = gw * 64 + lane;
      if (gt < SEQ * 8) { const int t = gt >> 3, i = gt & 7; const float inv = (float)exp(-((double)i / 8.0) * log(500000.0)); const float ang = (float)t * inv;
          float* tab = (float*)(ws + WS_ROPE); tab[t * 16 + i] = (float)cos((double)ang); tab[t * 16 + 8 + i] = (float)sin((double)ang); }
      if (gt < 8 * D) { const int j = gt >> 10, k = gt & 1023; ((float*)(ws + WS_GATEW))[gt] = a.in[13][(size_t)k * ML_PROJ + 3072 + j] * a.in[1][(size_t)(2 * 6 + 2) * D + k]; } }
    thin_phase(F, a.in[0], (bf16*)(ws + WS_XN), nullptr, nullptr, 0.f, (float*)(ws + WS_RS), nullptr, nullptr, nullptr);
}


typedef float f32x16 __attribute__((ext_vector_type(16)));
#define MFMA32(a, b, c) __builtin_amdgcn_mfma_f32_32x32x16_bf16((a), (b), (c), 0, 0, 0)
__device__ __forceinline__ bf16x8 as_frag(const v4u v) { return __builtin_bit_cast(bf16x8, v); }
__device__ __forceinline__ int pi32(int rho) { return (rho & ~12) | ((rho & 8) >> 1) | ((rho & 4) << 1); }
__device__ __forceinline__ v4u pack8(const float (&x)[8]) { v4u w; w.x = pg8::cvt_pk_bf16(x[0], x[1]); w.y = pg8::cvt_pk_bf16(x[2], x[3]); w.z = pg8::cvt_pk_bf16(x[4], x[5]); w.w = pg8::cvt_pk_bf16(x[6], x[7]); return w; }

__device__ __forceinline__ size_t ftr_off(int ftile, int p16, int slot) { return ((size_t)ftile * (M / 16) + p16) * 512 + slot * 8; }

__device__ __forceinline__ void attn_mfma(Frame& F, int g) {
    const int sh = 2 * g, L = SEQ >> sh, lt = 6 - sh;
    const bf16* QK = (const bf16*)(F.ws + WS_BIG); const bf16* VT = (const bf16*)(F.ws + WS_TR);
    bf16* OACC = (bf16*)(F.ws + WS_R2); float* LSE = (float*)(F.ws + WS_LSE);
    const LaneId li = lane_id(); const int lane = li.lane, r32 = lane & 31, hi = lane >> 5, pr = pi32(r32);
    const int gw = F.vcu * NWAVES + li.wave, NGW = F.G * NWAVES;
    for (int unit = gw; unit < BATCH * 16 * 64; unit += NGW) {
        const int bh = unit >> 6, t64 = unit & 63, b = bh >> 4, h = bh & 15;
        const int r = t64 >> lt, T = t64 & ((1 << lt) - 1);
        const size_t qrow = (size_t)(b << 11) + (size_t)(((32 * T + r32) << sh) + r);
        bf16x8 qf[4];
        { const GAS v4u* qp = (const GAS v4u*)(QK + (size_t)(((b * 64 + t64) * 16 + h) * 4) * 512 + (r32 + 32 * hi) * 8);
#pragma unroll
          for (int d0 = 0; d0 < 4; ++d0) qf[d0] = as_frag(qp[64 * d0]); }
        v4u kf[5][4];
#pragma unroll
        for (int j = 0; j < 5; ++j) { const int Tc = (T - 4 + j) < 0 ? 0 : (T - 4 + j);
            const GAS v4u* kp = (const GAS v4u*)(QK + (size_t)M * 1024 + (size_t)(((b * 64 + (r << lt) + Tc) * 16 + h) * 4) * 512 + (pr + 32 * hi) * 8);
#pragma unroll
            for (int d0 = 0; d0 < 4; ++d0) kf[j][d0] = kp[64 * d0]; }
        float lp = 0.f; if (g > 0) lp = LSE[qrow * 16 + h];
        f32x16 sc[5];
#pragma unroll
        for (int j = 0; j < 5; ++j) { f32x16 a;
#pragma unroll
            for (int i = 0; i < 16; ++i) a[i] = 0.f;
#pragma unroll
            for (int d0 = 0; d0 < 4; ++d0) a = MFMA32(as_frag(kf[j][d0]), qf[d0], a);
            sc[j] = a; }
        v4u vf[5][2][2];
#pragma unroll
        for (int j = 0; j < 5; ++j) { const int Tc = (T - 4 + j) < 0 ? 0 : (T - 4 + j);
#pragma unroll
            for (int db = 0; db < 2; ++db) { const int p16 = ((b << 11) + r * L + 32 * Tc) >> 4;
#pragma unroll
                for (int s = 0; s < 2; ++s) vf[j][db][s] = *(const GAS v4u*)(VT + ftr_off(2 * h + db, p16 + s, pr + 32 * hi)); } }
#pragma unroll
        for (int j = 0; j < 4; ++j) if ((T - 4 + j) < 0) {
#pragma unroll
            for (int i = 0; i < 16; ++i) sc[j][i] = -INFINITY; }
#pragma unroll
        for (int i = 0; i < 16; ++i) { const int kl = 16 * (i >> 3) + 8 * hi + (i & 7);
            sc[0][i] = (kl >= r32) ? sc[0][i] : -INFINITY; sc[4][i] = (kl <= r32) ? sc[4][i] : -INFINITY; }
        float mx = -INFINITY;
#pragma unroll
        for (int j = 0; j < 5; ++j)
#pragma unroll
            for (int i = 0; i < 16; i += 2) mx = fmaxf(fmaxf(mx, sc[j][i]), sc[j][i + 1]);
        mx = fmaxf(mx, __shfl_xor(mx, 32));
        float ls = 0.f; v4u pf[5][2];
#pragma unroll
        for (int j = 0; j < 5; ++j)
#pragma unroll
            for (int s = 0; s < 2; ++s) { float p[8];
#pragma unroll
                for (int e = 0; e < 8; ++e) { p[e] = __builtin_amdgcn_exp2f(sc[j][8 * s + e] - mx); ls += p[e]; }
                pf[j][s] = pack8(p); }
        ls += __shfl_xor(ls, 32);
        f32x16 o[2];
#pragma unroll
        for (int db = 0; db < 2; ++db)
#pragma unroll
            for (int i = 0; i < 16; ++i) o[db][i] = 0.f;
#pragma unroll
        for (int j = 0; j < 5; ++j)
#pragma unroll
            for (int db = 0; db < 2; ++db)
#pragma unroll
                for (int s = 0; s < 2; ++s) o[db] = MFMA32(as_frag(vf[j][db][s]), as_frag(pf[j][s]), o[db]);
        float inv = 1.f / ls, lse = mx + log2f(ls), wprev = 0.f;
        if (g > 0) { const float mm = fmaxf(lp, lse), e1 = exp2f(lp - mm), e2 = exp2f(lse - mm), den = e1 + e2;
            wprev = e1 / den; inv *= e2 / den; lse = mm + log2f(den); }
#pragma unroll
        for (int db = 0; db < 2; ++db)
#pragma unroll
            for (int s = 0; s < 2; ++s) { GAS v4u* op = (GAS v4u*)(OACC + qrow * LDX + h * 64 + 32 * db + 16 * s + 8 * hi); float x[8];
#pragma unroll
                for (int e = 0; e < 8; ++e) x[e] = o[db][8 * s + e] * inv;
                if (g > 0) { const v4u pv = *op;
#pragma unroll
                    for (int e = 0; e < 8; ++e) x[e] += wprev * bfel(pv, e); }
                *op = pack8(x); }
        if (hi == 0) LSE[qrow * 16 + h] = lse;
    }
}


__device__ __forceinline__ void mlstm_gate_prepass(Frame& F, const float* b_i, const float* b_f) {
    const float* GATES = (const float*)(F.ws + WS_GATES); float* GV = (float*)(F.ws + WS_GV);
    const LaneId li = lane_id(); const int lane = li.lane, gw = F.vcu * NWAVES + li.wave, NGW = F.G * NWAVES;
    for (int item = gw; item < 1024; item += NGW) {
        const int bh = item >> 5, c = item & 31, b = bh >> 2, h = bh & 3; const int tok = (b << 11) + c * 64 + lane;
        const float ig = GATES[(size_t)tok * 8 + h] + b_i[h]; const float lf = logsigmoid_f(GATES[(size_t)tok * 8 + 4 + h] + b_f[h]);
        const float bc = wave_incl_sum(lf, lane); const float u = ig - bc; const float run = wave_incl_max(u, lane);
        GV[(size_t)item * 192 + lane] = bc; GV[(size_t)item * 192 + 64 + lane] = u; GV[(size_t)item * 192 + 128 + lane] = run;
    }
}

__device__ __forceinline__ void mlstm_S_mfma(Frame& F) {
    const bf16* KVT = (const bf16*)(F.ws + WS_TR);
    bf16* CST = (bf16*)(F.ws + WS_R2); float* NST = (float*)(F.ws + WS_NST); float* MST = (float*)(F.ws + WS_MST); const float* GV = (const float*)(F.ws + WS_GV);
    const LaneId li = lane_id(); const int lane = li.lane, r32 = lane & 31, hi = lane >> 5, pr = pi32(r32), dvs = li.wave;
    LAS float* wsl = (LAS float*)(F.lds + li.wave * 512);
    for (int item = F.vcu; item < 128; item += F.G) {
        const int bh = item >> 2, dqt = item & 3, b = bh >> 2, h = bh & 3;
        f32x16 acc;
#pragma unroll
        for (int i = 0; i < 16; ++i) acc[i] = 0.f;
        float nacc = 0.f;
        const float bt_l = GV[(size_t)(bh * 32 + r32) * 192 + 63], am_l = GV[(size_t)(bh * 32 + r32) * 192 + 128 + 63];
        float marr = 0.f;
        { float m = 0.f;
          for (int c = 0; c < 32; ++c) { if (r32 == c) marr = m; m = __shfl(bt_l, c) + fmaxf(m, __shfl(am_l, c)); } }
        const GAS bf16* kTrow = (const GAS bf16*)KVT + ftr_off(4 * h + dqt, (b << 11) >> 4, pr + 32 * hi);
        const GAS bf16* vTrow = (const GAS bf16*)KVT + ftr_off(16 + 8 * h + dvs, (b << 11) >> 4, r32 + 32 * hi);
        v4u kfn[4], vrn[4]; float un;
#pragma unroll
        for (int ks = 0; ks < 4; ++ks) { kfn[ks] = *(const GAS v4u*)(kTrow + 512 * ks); vrn[ks] = *(const GAS v4u*)(vTrow + 512 * ks); }
        un = GV[(size_t)(bh * 32) * 192 + 64 + lane];
        for (int c = 0; c < 32; ++c) {
            const size_t sidx = (size_t)(bh * 32 + c);
            v4u kfc[4], vrc[4]; const float uc = un;
#pragma unroll
            for (int ks = 0; ks < 4; ++ks) { kfc[ks] = kfn[ks]; vrc[ks] = vrn[ks]; }
            { const int cn = c < 31 ? c + 1 : 31;
#pragma unroll
              for (int ks = 0; ks < 4; ++ks) { kfn[ks] = *(const GAS v4u*)(kTrow + (4 * cn + ks) * 512); vrn[ks] = *(const GAS v4u*)(vTrow + (4 * cn + ks) * 512); }
              un = GV[(size_t)(bh * 32 + cn) * 192 + 64 + lane]; }
#pragma unroll
            for (int s = 0; s < 2; ++s) { float x[8];
#pragma unroll
                for (int e = 0; e < 8; ++e) x[e] = acc[8 * s + e];
                *(GAS v4u*)(CST + (((sidx * 8 + dvs) * 4 + dqt) * 2 + s) * 512 + lane * 8) = pack8(x); }
            if (dvs == 0 && hi == 0) NST[sidx * 128 + 32 * dqt + pr] = nacc;
            const float m_prev = __shfl(marr, c), btot = __shfl(bt_l, c), m_new = btot + fmaxf(m_prev, __shfl(am_l, c));
            if (dvs == 0 && dqt == 0 && lane == 0) MST[sidx] = m_prev;
            const float we = expf(uc + btot - m_new); const float decay = expf(btot + m_prev - m_new);
            wsl[lane] = we;
            LDS_WAIT(); __builtin_amdgcn_wave_barrier();
#pragma unroll
            for (int i = 0; i < 16; ++i) acc[i] *= decay;
            float nsum = 0.f;
#pragma unroll
            for (int ks = 0; ks < 4; ++ks) {
                const v4u kf = kfc[ks]; const v4u vr = vrc[ks];
                const f32x4 w0 = *(const LAS f32x4*)(wsl + 16 * ks + 8 * hi), w1 = *(const LAS f32x4*)(wsl + 16 * ks + 8 * hi + 4);
                float x[8];
#pragma unroll
                for (int e = 0; e < 8; ++e) { const float w = (e < 4) ? w0[e & 3] : w1[e & 3]; x[e] = bfel(vr, e) * w; nsum += bfel(kf, e) * w; }
                acc = MFMA32(as_frag(kf), as_frag(pack8(x)), acc);
            }
            nsum += __shfl_xor(nsum, 32);
            nacc = decay * nacc + nsum;
            LDS_WAIT(); __builtin_amdgcn_wave_barrier();
        }
    }
}

__device__ __forceinline__ void mlstm_O_mfma(Frame& F) {
    const bf16* QKO = (const bf16*)(F.ws + WS_BIG); const bf16* KVT = (const bf16*)(F.ws + WS_TR);
    const bf16* CST = (const bf16*)(F.ws + WS_R2); const float* NST = (const float*)(F.ws + WS_NST); const float* MST = (const float*)(F.ws + WS_MST); const float* GV = (const float*)(F.ws + WS_GV);
    bf16* HOG = (bf16*)(F.ws + WS_BIG) + (size_t)M * 1024;
    const LaneId li = lane_id(); const int lane = li.lane, r32 = lane & 31, hi = lane >> 5, pr = pi32(r32), th = li.wave >> 2, dvq = li.wave & 3;
    LAS float* gl = (LAS float*)(F.lds + li.wave * 2048);
    constexpr float LOG2E = 1.4426950408889634f;
    for (int item = F.vcu; item < 1024; item += F.G) {
        const int bh = item >> 5, c = item & 31, b = bh >> 2, h = bh & 3; const int tok0 = (b << 11) + c * 64;
        const int t = 32 * th + r32;
        const float g_bc = GV[(size_t)item * 192 + lane], g_u = GV[(size_t)item * 192 + 64 + lane], g_run = GV[(size_t)item * 192 + 128 + lane];
        const float m_prev = ld_f32_coherent(MST + item);
        const float n_lo = NST[(size_t)item * 128 + lane], n_hi = NST[(size_t)item * 128 + 64 + lane];
        v4u cfr[2][8];
        { const GAS v4u* cp = (const GAS v4u*)(CST + (((size_t)item * 8 + 2 * dvq) * 8) * 512 + (pr + 32 * hi) * 8);
#pragma unroll
          for (int ks = 0; ks < 8; ++ks) cfr[0][ks] = cp[64 * ks]; }
        bf16x8 qf[8];
        { const GAS v4u* qp = (const GAS v4u*)(QKO + (size_t)((((tok0 >> 5) + th) * 4 + h) * 8) * 512 + (r32 + 32 * hi) * 8);
#pragma unroll
          for (int ks = 0; ks < 8; ++ks) qf[ks] = as_frag(qp[64 * ks]); }
        v4u kfr[2][8];
#pragma unroll
        for (int st = 0; st < 2; ++st) { const GAS v4u* kp = (const GAS v4u*)(QKO + (size_t)M * 512 + (size_t)((((tok0 >> 5) + st) * 4 + h) * 8) * 512 + (pr + 32 * hi) * 8);
#pragma unroll
            for (int ks = 0; ks < 8; ++ks) kfr[st][ks] = kp[64 * ks]; }
        { const float mt = g_bc + fmaxf(m_prev, g_run);
          gl[lane] = g_u * LOG2E; gl[64 + lane] = (g_bc - mt) * LOG2E; gl[128 + lane] = expf(g_bc + m_prev - mt); gl[192 + lane] = expf(-mt); gl[256 + lane] = n_lo; gl[320 + lane] = n_hi; }
        __builtin_amdgcn_wave_barrier();
        const float e2 = gl[64 + t], wit = gl[128 + t], emt = gl[192 + t];
        f32x16 sacc[2];
#pragma unroll
        for (int st = 0; st < 2; ++st) { f32x16 a;
#pragma unroll
            for (int i = 0; i < 16; ++i) a[i] = 0.f;
            if (st <= th) {
#pragma unroll
                for (int ks = 0; ks < 8; ++ks) a = MFMA32(as_frag(kfr[st][ks]), qf[ks], a);
            }
            sacc[st] = a; }
        { const GAS v4u* cp = (const GAS v4u*)(CST + (((size_t)item * 8 + 2 * dvq + 1) * 8) * 512 + (pr + 32 * hi) * 8);
#pragma unroll
          for (int ks = 0; ks < 8; ++ks) cfr[1][ks] = cp[64 * ks]; }
        v4u vfr[2][4];
#pragma unroll
        for (int dt = 0; dt < 2; ++dt) { const GAS v4u* vp = (const GAS v4u*)(KVT + ftr_off(16 + 8 * h + 2 * dvq + dt, tok0 >> 4, pr + 32 * hi));
#pragma unroll
            for (int j = 0; j < 4; ++j) vfr[dt][j] = vp[64 * j]; }
        v4u ogv[2][2];
#pragma unroll
        for (int dt = 0; dt < 2; ++dt)
#pragma unroll
            for (int s2 = 0; s2 < 2; ++s2) ogv[dt][s2] = *(const GAS v4u*)(HOG + (size_t)(tok0 + t) * 1024 + (size_t)h * 256 + 64 * dvq + 32 * dt + 16 * s2 + 8 * hi);
        float dsum = 0.f; v4u af[2][2];
#pragma unroll
        for (int st = 0; st < 2; ++st)
#pragma unroll
            for (int s2 = 0; s2 < 2; ++s2) { float x[8];
#pragma unroll
                for (int e = 0; e < 8; ++e) { const int sl = 16 * s2 + 8 * hi + e; const float w = __builtin_amdgcn_exp2f(e2 + gl[32 * st + sl]);
                    const bool ok = (st < th) || (st == th && sl <= r32); x[e] = ok ? sacc[st][8 * s2 + e] * w : 0.f; dsum += x[e]; }
                af[st][s2] = pack8(x); }
        dsum += __shfl_xor(dsum, 32);
        float nq = 0.f;
#pragma unroll
        for (int ks = 0; ks < 8; ++ks) { const f32x4 n0 = *(const LAS f32x4*)(gl + 256 + 16 * ks + 8 * hi), n1 = *(const LAS f32x4*)(gl + 256 + 16 * ks + 8 * hi + 4);
            const v4u qv = __builtin_bit_cast(v4u, qf[ks]);
            nq += n0.x * bflo(qv.x) + n0.y * bfhi(qv.x) + n0.z * bflo(qv.y) + n0.w * bfhi(qv.y) + n1.x * bflo(qv.z) + n1.y * bfhi(qv.z) + n1.z * bflo(qv.w) + n1.w * bfhi(qv.w); }
        nq += __shfl_xor(nq, 32);
        const float den = dsum + wit * nq; const float inv = 1.f / fmaxf(fabsf(den), emt);
        f32x16 hacc[2];
#pragma unroll
        for (int dt = 0; dt < 2; ++dt) { f32x16 a;
#pragma unroll
            for (int i = 0; i < 16; ++i) a[i] = 0.f;
#pragma unroll
            for (int ks = 0; ks < 8; ++ks) a = MFMA32(as_frag(cfr[dt][ks]), qf[ks], a);
#pragma unroll
            for (int i = 0; i < 16; ++i) a[i] *= wit;
#pragma unroll
            for (int st = 0; st < 2; ++st)
                if (st <= th) {
#pragma unroll
                    for (int s2 = 0; s2 < 2; ++s2) a = MFMA32(as_frag(vfr[dt][2 * st + s2]), as_frag(af[st][s2]), a);
                }
            hacc[dt] = a; }
#pragma unroll
        for (int dt = 0; dt < 2; ++dt)
#pragma unroll
            for (int s2 = 0; s2 < 2; ++s2) { float x[8];
#pragma unroll
                for (int e = 0; e < 8; ++e) x[e] = hacc[dt][8 * s2 + e] * inv * __builtin_amdgcn_rcpf(1.f + __builtin_amdgcn_exp2f(-LOG2E * bfel(ogv[dt][s2], e)));
                *(GAS v4u*)(HOG + (size_t)(tok0 + t) * 1024 + (size_t)h * 256 + 64 * dvq + 32 * dt + 16 * s2 + 8 * hi) = pack8(x); }
        __builtin_amdgcn_wave_barrier();
    }
}

#ifndef PROBE_PROLOGUE
#define PROBE_PROLOGUE 1
#endif
#ifndef PROBE_GEMM
#define PROBE_GEMM 1
#endif
#ifndef PROBE_THIN
#define PROBE_THIN 0
#endif
#ifndef PROBE_ATT0
#define PROBE_ATT0 0
#endif
#ifndef PROBE_MLS
#define PROBE_MLS 1
#endif
#ifndef PROBE_MLO
#define PROBE_MLO 1
#endif
#ifndef PROBE_UP
#define PROBE_UP 1
#endif
#ifndef PROBE_DOWN
#define PROBE_DOWN 1
#endif
#ifndef PROBE_BAR
#define PROBE_BAR 1
#endif
#ifndef MK_SPLIT
#define MK_SPLIT 0
#endif
constexpr int N_PHASE_IDS = 1 + 8 * 12;
__host__ __device__ inline bool phase_nonempty(int id) {
    if (id == 0) return true;
    const int s = (id - 1) >> 3, k = (id - 1) & 7, sub = s % 3, mix = (s / 3) % 3;
    if (k >= 6) return true;
    if (sub != 1) return k == 0;
    if (mix == 0) return k <= 1;
    if (mix == 1) return k <= 5;
    return k <= 2;
}

__global__ void __launch_bounds__(NWAVES * 64, 2) mk_fwd(Args args) {
    extern __shared__ __attribute__((aligned(16))) unsigned char lds[];
    Frame F;
    F.lds = (LAS unsigned char*)lds;
    F.MISC = (volatile LAS unsigned*)(F.lds + MISC_OFF);
    F.G = gridDim.x; { const int bx = blockIdx.x; F.vcu = (F.G % 8 == 0) ? (bx % 8) * (F.G / 8) + bx / 8 : bx; }
    F.ws = args.ws; F.ctl = (gu32*)(args.ws + WS_CTL);
    unsigned char* ws = args.ws;
    for (int u = threadIdx.x; u < (LDS_BYTES - MISC_OFF) / 4; u += NWAVES * 64) ((LAS unsigned*)(F.lds + MISC_OFF))[u] = 0u;
    __syncthreads();
#if MK_SPLIT
    const int lo = args.ph_lo, hi = args.ph_hi;
    int pid = 0;
#define RUN(k) ((pid = (k)), (lo <= pid && pid < hi))
#define SEAM() do { } while (0)
#else
    (void)xcd_barrier_post((unsigned*)(F.ctl + CW_BAR), F.MISC + 8);
    int pid = 0;
#define RUN(k) ((pid = (k)), true)
#define SEAM() do { if (pid + 1 < N_PHASE_IDS) { for (int pb_ = 0; pb_ < PROBE_BAR; ++pb_) { XcdBarrier bar_; bar_.bar = (unsigned*)(F.ctl + CW_BAR); bar_.x = xb_xcc_id(); bar_.st = F.MISC + 8; xcd_barrier(bar_); } } } while (0)
#endif

    bf16* const XN = (bf16*)(ws + WS_XN); bf16* const BIG = (bf16*)(ws + WS_BIG); bf16* const Y = (bf16*)(ws + WS_Y); bf16* const R2 = (bf16*)(ws + WS_R2);
    const float* const rope = (const float*)(ws + WS_ROPE);

    if (RUN(0)) { for (int pp_ = 0; pp_ < PROBE_PROLOGUE; ++pp_) prologue(F, args); SEAM(); }

    for (int s = 0; s < 12; ++s) {
        const int layer = s / 3, sub = s - 3 * layer, mix = layer % 3, mj = layer / 3, base = 1 + 8 * s;
        const bool is_ffn = (sub != 1);
        const int nrep = (!is_ffn && mix == 1) ? 3 : 1;
        for (int rep = 0; rep < nrep; ++rep) {
            if (RUN(base + 2 * rep)) {
                if (!is_ffn && mix == 2) mlstm_gate_prepass(F, args.in[14] + mj * 4, args.in[15] + mj * 4);
                {   pg8::Gemm g; pg8::EpiX E;
                    g.A = XN; g.M = M; g.K = D; g.lda = LDX; g.ldb = D; g.bdil = 1; E.O = BIG; E.O2 = nullptr; E.rope = rope; E.qscale = 1.f; E.rs = (const float*)(ws + WS_RS); E.rsm = 1; E.cdil = 1; E.gsh = 0;
                    if (is_ffn) { g.Bt = (const bf16*)(ws + WS_WUP) + (size_t)(layer * 2 + (sub >> 1)) * (2 * FF) * D; g.N = 2 * FF; E.mode = 1; E.ldc = FF; }
                    else if (mix == 0) { g.Bt = (const bf16*)(ws + WS_WCIN) + (size_t)mj * 3072 * D; g.N = 3072; E.mode = 2; E.ldc = 1024; E.O2 = BIG + (size_t)M * 1024; }
                    else if (mix == 1) { g.Bt = (const bf16*)(ws + WS_WAIN) + (size_t)(rep * 3072) * D; g.N = 2048; E.mode = 3; E.ldc = LDQ; E.qscale = ATT_QSCALE; E.gsh = 2 * rep; }
                    else { g.Bt = (const bf16*)(ws + WS_WMIN); g.N = 2048; E.mode = 4; E.ldc = LDQ; E.qscale = ML_QSCALE; E.O2 = BIG + (size_t)M * 1024; }
                    pg8::StaticOrder S; S.init(g.M, g.N, F.G, (int)blockIdx.x); for (int pg_ = 0; pg_ < (is_ffn ? PROBE_UP : 1) * PROBE_GEMM; ++pg_) pg8::gemm_phase<pg8::EpiX, pg8::StaticOrder>(F.lds + RING_OFF, g, S, E); }
                if (is_ffn) {
                    const int nwg_ = (M / 256) * (2 * FF / 256), rem_ = nwg_ % (int)F.G; const int c_ = (int)blockIdx.x;
                    const int first_ = rem_ > 0 ? rem_ : 0;
                    if (c_ >= first_) { const LaneId lj = lane_id(); const int wrank = (c_ - first_) * NWAVES + lj.wave, nw = ((int)F.G - first_) * NWAVES;
                        if (sub == 0) {
                            if (mix == 0) { convert_range(F, args, CV_O_CIN + mj * 768, 768, wrank, nw); convert_range(F, args, CV_O_COUT + mj * 256, 256, wrank, nw); }
                            else if (mix == 1) convert_range(F, args, CV_O_ATT, CV_AIN + CV_AOUT, wrank, nw);
                            else convert_range(F, args, CV_O_ML, CV_MIN + CV_MOUT, wrank, nw);
                            convert_ffn(F, args, layer, 1, wrank, nw);
                        } else if (layer < DEPTH - 1) convert_ffn(F, args, layer + 1, 0, wrank, nw);
                    }
                }
                if (!is_ffn && mix != 0) {
                    pg8::Gemm g; pg8::EpiX E;
                    g.Bt = XN; g.N = M; g.K = D; g.lda = D; g.ldb = LDX; E.mode = 0; E.O = (bf16*)(ws + WS_TR); E.ldc = M; E.O2 = nullptr; E.rope = rope; E.qscale = 1.f; E.rs = (const float*)(ws + WS_RS); E.rsm = 2; E.cdil = 1; E.gsh = 0;
                    if (mix == 1) { g.A = (const bf16*)(ws + WS_WAIN) + (size_t)(rep * 3072 + 2048) * D; g.M = 1024; g.bdil = 1 << (2 * rep); E.cdil = g.bdil; }
                    else { g.A = (const bf16*)(ws + WS_WMIN) + (size_t)2048 * D; g.M = 1536; g.bdil = 1; }
                    pg8::StaticOrder S; S.init(g.M, g.N, F.G, (int)blockIdx.x); for (int pg_ = 0; pg_ < PROBE_GEMM; ++pg_) pg8::gemm_phase<pg8::EpiX, pg8::StaticOrder>(F.lds + RING_OFF, g, S, E); }
                SEAM();
            }
            if (!is_ffn && RUN(base + 2 * rep + 1)) {
                if (mix == 0) conv_phase(F, BIG, BIG + (size_t)M * 1024, args.in[9] + (size_t)mj * 3 * D);
                else if (mix == 1) { if (rep == 0) for (int pa_ = 0; pa_ < PROBE_ATT0; ++pa_) attn_mfma(F, 0); attn_mfma(F, rep); }
                else for (int ps_ = 0; ps_ < PROBE_MLS; ++ps_) mlstm_S_mfma(F);
                SEAM();
            }
        }
        if (!is_ffn && mix == 2 && RUN(base + 2)) { for (int po_ = 0; po_ < PROBE_MLO; ++po_) mlstm_O_mfma(F); SEAM(); }
        if (RUN(base + 6)) {
            pg8::Gemm g; g.M = M; g.N = D; g.bdil = 1; g.K = D; g.lda = D; g.ldb = D;
            if (is_ffn) { g.A = BIG; g.K = FF; g.lda = FF; g.ldb = FF; g.Bt = (const bf16*)(ws + WS_WDN) + (size_t)(layer * 2 + (sub >> 1)) * D * FF; }
            else if (mix == 0) { g.A = BIG; g.Bt = (const bf16*)(ws + WS_WCOUT) + (size_t)mj * D * D; }
            else if (mix == 1) { g.A = R2; g.lda = LDX; g.Bt = (const bf16*)(ws + WS_WAOUT); }
            else { g.A = BIG + (size_t)M * 1024; g.lda = D; g.Bt = (const bf16*)(ws + WS_WMOUT); }
            pg8::EpiX E; E.mode = 0; E.O = Y; E.ldc = D; E.O2 = nullptr; E.rope = rope; E.qscale = 1.f; E.rs = nullptr; E.rsm = 0; E.cdil = 1; E.gsh = 0;
            pg8::StaticOrder S; S.init(g.M, g.N, F.G, (int)blockIdx.x);
            for (int pg_ = 0; pg_ < (is_ffn ? PROBE_DOWN : 1) * PROBE_GEMM; ++pg_) pg8::gemm_phase<pg8::EpiX, pg8::StaticOrder>(F.lds + RING_OFF, g, S, E);
            SEAM();
        }
        if (RUN(base + 7)) {
            const float* gpost = args.in[1] + (size_t)(layer * 6 + 2 * sub + 1) * D;
            const bool last = (s == 11); const bool want_gates = (sub == 0 && mix == 2);
            for (int pt_ = 0; pt_ < PROBE_THIN; ++pt_) thin_phase(F, nullptr, XN, Y, gpost, 0.f, (float*)(ws + WS_RS), nullptr, nullptr, nullptr);
            thin_phase(F, nullptr, XN, Y, gpost, is_ffn ? 0.5f : 1.0f, (float*)(ws + WS_RS), last ? args.out : nullptr, want_gates ? (const float*)(ws + WS_GATEW) : nullptr, (float*)(ws + WS_GATES));
            SEAM();
        }
    }
#undef RUN
#undef SEAM
}

extern "C" void kernel_launch(void* const* d_in, const int* in_sizes, int n_in, void* d_out, int out_size, void* d_ws, size_t ws_size, hipStream_t stream) {
    static int grid = 0;
    if (grid == 0) {
        if (n_in != 17 || in_sizes[0] != M * D || out_size != M * D || ws_size < WS_END) { fprintf(stderr, "kernel_launch: unexpected shapes (n_in %d, in0 %d, out %d, ws %zu < %zu); nothing launched\n", n_in, n_in > 0 ? in_sizes[0] : -1, out_size, ws_size, (size_t)WS_END); grid = -1; return; }
        int dev = 0, cus = 0, per_cu = 0;
        if (hipGetDevice(&dev) != hipSuccess || hipDeviceGetAttribute(&cus, hipDeviceAttributeMultiprocessorCount, dev) != hipSuccess) { grid = -1; return; }
        if (hipFuncSetAttribute((const void*)mk_fwd, hipFuncAttributeMaxDynamicSharedMemorySize, LDS_BYTES) != hipSuccess) { fprintf(stderr, "kernel_launch: hipFuncSetAttribute failed\n"); grid = -1; return; }
        if (hipOccupancyMaxActiveBlocksPerMultiprocessor(&per_cu, (const void*)mk_fwd, NWAVES * 64, LDS_BYTES) != hipSuccess || per_cu < 1)
            fprintf(stderr, "kernel_launch: note: occupancy query reports %d workgroups per CU\n", per_cu);
        (void)hipGetLastError();
        grid = cus;
    }
    if (grid < 0) return;
    if (hipMemsetAsync((char*)d_ws + WS_CTL, 0, CTL_ZERO_BYTES, stream) != hipSuccess) return;
    Args a{};
    for (int i = 0; i < 17; ++i) a.in[i] = (const float*)d_in[i];
    a.out = (float*)d_out; a.ws = (unsigned char*)d_ws;
#if MK_SPLIT
    for (int id = 0; id < N_PHASE_IDS; ++id) { if (!phase_nonempty(id)) continue; a.ph_lo = id; a.ph_hi = id + 1;
        hipLaunchKernelGGL(mk_fwd, dim3(grid), dim3(NWAVES * 64), LDS_BYTES, stream, a); }
#else
    a.ph_lo = 0; a.ph_hi = N_PHASE_IDS;
    hipLaunchKernelGGL(mk_fwd, dim3(grid), dim3(NWAVES * 64), LDS_BYTES, stream, a);
#endif
    const hipError_t le = hipPeekAtLastError();
    if (le != hipSuccess) fprintf(stderr, "kernel_launch: launch failed: %s\n", hipGetErrorName(le));
}
```
